# Optimizing an MI355X kernel written in HIP

```python
import math
import jax, jax.numpy as jnp
from jax import lax
import numpy as np

D_MODEL = 1024
BATCH = 8
SEQ = 4096
DEPTH = 1

MIX_WIDTH = D_MODEL
ATT_HEAD_DIM = 64
ATT_HEADS = (MIX_WIDTH // 2) // ATT_HEAD_DIM
ATT_KV_HEADS = max(1, ATT_HEADS // 4)
ATT_GROUP = ATT_HEADS // ATT_KV_HEADS
ATT_SCALE = ATT_HEAD_DIM ** -0.5
WINDOW = 128
BLOCK = WINDOW
N_BUCKETS = 32
MAX_DISTANCE = 128
HG_DK = 128
HG_DV = 128
HG_HEADS = (MIX_WIDTH // 2) // HG_DV
CHUNK = 64
N_EXPERTS = 32
TOP_K = 4
D_FF = D_MODEL
SWIGLU_LIMIT = 7.0
SWIGLU_ALPHA = 1.702
EPS = 1e-5

ATT_Q = ATT_HEADS * ATT_HEAD_DIM
ATT_KV = ATT_KV_HEADS * ATT_HEAD_DIM
HG_K = HG_HEADS * HG_DK
HG_V = HG_HEADS * HG_DV
OUT_IN = ATT_Q + HG_V
IN_SIZES = (ATT_Q, ATT_KV, ATT_KV, HG_K, HG_K, HG_V, HG_V)
IN_COLS = sum(IN_SIZES)
IN_SPLITS = tuple(sum(IN_SIZES[:j + 1]) for j in range(len(IN_SIZES) - 1))

kernel_name = 'hymba_swa_sink_hgrn2_moe_adaln'


def rms_norm(x, g):
    xf = x.astype(jnp.float32)
    y = xf * lax.rsqrt(jnp.mean(xf * xf, axis=-1, keepdims=True) + EPS)
    return (y * g.astype(jnp.float32)).astype(x.dtype)


def t5_causal_bucket(dist):
    n = jnp.maximum(dist, 0)
    max_exact = N_BUCKETS // 2
    nf = jnp.maximum(n, 1).astype(jnp.float32)
    large = max_exact + (jnp.log(nf / max_exact) / math.log(MAX_DISTANCE / max_exact)
                         * (N_BUCKETS - max_exact)).astype(jnp.int32)
    large = jnp.minimum(large, N_BUCKETS - 1)
    return jnp.where(n < max_exact, n, large)


def band_structure(rel_bias, n_blocks):
    i = jnp.arange(BLOCK, dtype=jnp.int32)[:, None]
    m = jnp.arange(2 * BLOCK, dtype=jnp.int32)[None, :]
    dist = i + BLOCK - m
    in_window = (dist >= 0) & (dist < WINDOW)
    bias = rel_bias.astype(jnp.float32)[t5_causal_bucket(dist)]
    bias = jnp.transpose(bias, (2, 0, 1)).reshape(ATT_KV_HEADS, ATT_GROUP, BLOCK, 2 * BLOCK)
    blk = jnp.arange(n_blocks, dtype=jnp.int32)[:, None, None]
    key_exists = (blk > 0) | (m[None] >= BLOCK)
    valid = in_window[None] & key_exists
    return bias, valid


def sliding_window_attention(q, k, v, sinks, band_bias, valid):
    B, S = q.shape[0], q.shape[1]
    nb = S // BLOCK
    qb = q.reshape(B, nb, BLOCK, ATT_KV_HEADS, ATT_GROUP, ATT_HEAD_DIM)

    def band(t):
        prev = jnp.pad(t, ((0, 0), (BLOCK, 0), (0, 0), (0, 0)))[:, :S]
        prev = prev.reshape(B, nb, BLOCK, ATT_KV_HEADS, ATT_HEAD_DIM)
        cur = t.reshape(B, nb, BLOCK, ATT_KV_HEADS, ATT_HEAD_DIM)
        return jnp.concatenate([prev, cur], axis=2)

    kb, vb = band(k), band(v)
    s = jnp.einsum('bnqkgd,bnskd->bnkgqs', qb, kb).astype(jnp.float32) * ATT_SCALE + band_bias
    s = jnp.where(valid[None, :, None, None], s, -jnp.inf)
    sink = jnp.broadcast_to(sinks.astype(jnp.float32).reshape(ATT_KV_HEADS, ATT_GROUP, 1, 1),
                            s.shape[:-1] + (1,))
    p = jax.nn.softmax(jnp.concatenate([s, sink], axis=-1), axis=-1)[..., :-1]
    o = jnp.einsum('bnkgqs,bnskd->bnqkgd', p.astype(v.dtype), vb)
    return o.reshape(B, S, ATT_Q)


def hgrn2_chunkwise(q, f_logit, inp, lb):
    B, S, H, DK = q.shape
    DV = inp.shape[-1]
    nc = S // CHUNK
    f = lb + (1.0 - lb) * jax.nn.sigmoid(f_logit.astype(jnp.float32))
    log_f = jnp.log(f)
    kk = 1.0 - f
    qf = jax.nn.silu(q.astype(jnp.float32))

    def to_chunks(t):
        return t.reshape(B, nc, CHUNK, H, t.shape[-1]).transpose(1, 0, 3, 2, 4)

    causal = jnp.tril(jnp.ones((CHUNK, CHUNK), dtype=bool))[:, :, None]

    def step(state, xs):
        qc, kc, vc, gc = xs
        b = jnp.cumsum(gc, axis=2)
        b_end = b[:, :, -1:, :]
        decay = jnp.exp(jnp.where(causal, b[:, :, :, None, :] - b[:, :, None, :, :], -jnp.inf))
        scores = jnp.einsum('bhtk,bhsk,bhtsk->bhts', qc, kc, decay)
        o = (jnp.einsum('bhts,bhsv->bhtv', scores, vc)
             + jnp.einsum('bhtk,bhkv->bhtv', qc * jnp.exp(b), state))
        state = (jnp.exp(b_end[:, :, 0, :, None]) * state
                 + jnp.einsum('bhsk,bhsv->bhkv', kc * jnp.exp(b_end - b), vc))
        return state, o

    state0 = jnp.zeros((B, H, DK, DV), jnp.float32)
    _, o = lax.scan(step, state0, (to_chunks(qf), to_chunks(kk),
                                   to_chunks(inp.astype(jnp.float32)), to_chunks(log_f)))
    return o.transpose(1, 0, 3, 2, 4).reshape(B, S, H, DV).astype(inp.dtype)


def moe_ffn(h, w_router, b_router, w_gate_up, b_gate_up, w_down, b_down):
    B, S, D = h.shape
    t = h.reshape(B * S, D)
    logits = (t @ w_router + b_router).astype(jnp.float32)
    top_val, top_idx = lax.top_k(logits, TOP_K)
    top_w = jax.nn.softmax(top_val, axis=-1)
    combine = jnp.sum(jax.nn.one_hot(top_idx, N_EXPERTS, dtype=jnp.float32) * top_w[..., None], axis=1)
    out = jnp.zeros((B * S, D), jnp.float32)
    for e in range(N_EXPERTS):
        gu = t @ w_gate_up[e] + b_gate_up[e]
        gate = jnp.minimum(gu[:, 0::2], SWIGLU_LIMIT)
        up = jnp.clip(gu[:, 1::2], -SWIGLU_LIMIT, SWIGLU_LIMIT)
        y = ((up + 1.0) * gate * jax.nn.sigmoid(SWIGLU_ALPHA * gate)) @ w_down[e] + b_down[e]
        out = out + combine[:, e:e + 1] * y.astype(jnp.float32)
    return out.astype(h.dtype).reshape(B, S, D)


def setup_inputs(seed: int = 0) -> dict:
    key = jax.random.key(seed)
    ks = jax.random.split(key, 24)
    f32 = jnp.float32
    L = DEPTH

    def nrm(k, shape, scale):
        return scale * jax.random.normal(k, shape, f32)

    return {
        'x': nrm(ks[0], (BATCH, SEQ, D_MODEL), 1.0),
        'c': nrm(ks[1], (BATCH, D_MODEL), 1.0),
        'w_ada': nrm(ks[2], (L, D_MODEL, 6 * D_MODEL), 0.5 * D_MODEL ** -0.5),
        'b_ada': nrm(ks[3], (L, 6 * D_MODEL), 0.02),
        'g_mix': 1.0 + nrm(ks[4], (L, D_MODEL), 0.02),
        'w_in': nrm(ks[5], (L, D_MODEL, IN_COLS), D_MODEL ** -0.5),
        'b_in': nrm(ks[6], (L, IN_COLS), 0.02),
        'attn_sinks': nrm(ks[7], (L, ATT_HEADS), 0.5),
        'rel_bias': nrm(ks[8], (N_BUCKETS, ATT_HEADS), 0.5),
        'hg_lb': nrm(ks[9], (L + 1, HG_K), 1.0),
        'hg_norm_w': 1.0 + nrm(ks[10], (L, HG_DV), 0.02),
        'w_out': nrm(ks[11], (L, OUT_IN, D_MODEL), OUT_IN ** -0.5),
        'b_out': nrm(ks[12], (L, D_MODEL), 0.02),
        'g_ffn': 1.0 + nrm(ks[13], (L, D_MODEL), 0.02),
        'w_router': nrm(ks[14], (L, D_MODEL, N_EXPERTS), D_MODEL ** -0.5),
        'b_router': nrm(ks[15], (L, N_EXPERTS), 0.01),
        'w_gate_up': nrm(ks[16], (L, N_EXPERTS, D_MODEL, 2 * D_FF), D_MODEL ** -0.5),
        'b_gate_up': nrm(ks[17], (L, N_EXPERTS, 2 * D_FF), 0.02),
        'w_down': nrm(ks[18], (L, N_EXPERTS, D_FF, D_MODEL), D_FF ** -0.5),
        'b_down': nrm(ks[19], (L, N_EXPERTS, D_MODEL), 0.02),
        'g_final': 1.0 + nrm(ks[20], (D_MODEL,), 0.02),
    }


def reference(x, c, w_ada, b_ada, g_mix, w_in, b_in, attn_sinks, rel_bias, hg_lb, hg_norm_w,
              w_out, b_out, g_ffn, w_router, b_router, w_gate_up, b_gate_up, w_down, b_down,
              g_final):
    B, S, D = x.shape
    band_bias, valid = band_structure(rel_bias, S // BLOCK)
    lb_all = jnp.cumsum(jax.nn.softmax(hg_lb.astype(jnp.float32), axis=0), axis=0)
    cond = jax.nn.silu(c)
    for l in range(DEPTH):
        mod = (cond @ w_ada[l] + b_ada[l]).reshape(B, 6, 1, D)
        sh1, sc1, gt1, sh2, sc2, gt2 = (mod[:, j] for j in range(6))

        h = rms_norm(x, g_mix[l]) * (1.0 + sc1) + sh1
        proj = h @ w_in[l] + b_in[l]
        aq, ak, av, hq, hf, hi, hg = jnp.split(proj, IN_SPLITS, axis=-1)
        y_att = sliding_window_attention(
            aq.reshape(B, S, ATT_HEADS, ATT_HEAD_DIM),
            ak.reshape(B, S, ATT_KV_HEADS, ATT_HEAD_DIM),
            av.reshape(B, S, ATT_KV_HEADS, ATT_HEAD_DIM),
            attn_sinks[l], band_bias, valid)
        o_hg = hgrn2_chunkwise(
            hq.reshape(B, S, HG_HEADS, HG_DK),
            hf.reshape(B, S, HG_HEADS, HG_DK),
            hi.reshape(B, S, HG_HEADS, HG_DV),
            lb_all[l].reshape(HG_HEADS, HG_DK))
        o_hg = rms_norm(o_hg, hg_norm_w[l]) * jax.nn.silu(hg.reshape(B, S, HG_HEADS, HG_DV))
        mixed = jnp.concatenate([y_att, o_hg.reshape(B, S, HG_V)], axis=-1)
        x = x + gt1 * (mixed @ w_out[l] + b_out[l])

        h = rms_norm(x, g_ffn[l]) * (1.0 + sc2) + sh2
        x = x + gt2 * moe_ffn(h, w_router[l], b_router[l], w_gate_up[l], b_gate_up[l],
                              w_down[l], b_down[l])
    return rms_norm(x, g_final)
```

```cpp
#include <hip/hip_runtime.h>
#include <cstdio>
#include <cstdint>

#ifndef MK_PER_PHASE
#define MK_PER_PHASE 0
#endif

#define GAS __attribute__((address_space(1)))
#define LAS __attribute__((address_space(3)))
typedef unsigned short bf16;
typedef unsigned v4u __attribute__((ext_vector_type(4)));
typedef unsigned v2u __attribute__((ext_vector_type(2)));
typedef float f32x4 __attribute__((ext_vector_type(4)));
typedef float f32x2 __attribute__((ext_vector_type(2)));
typedef short bf16x8 __attribute__((ext_vector_type(8)));
#define RLX_AGENT __ATOMIC_RELAXED, __HIP_MEMORY_SCOPE_AGENT
#define LDS_WAIT() asm volatile("s_waitcnt lgkmcnt(0)" ::: "memory")
#define VM_WAIT() asm volatile("s_waitcnt vmcnt(0)" ::: "memory")
#define LDS_BARRIER() asm volatile("s_waitcnt lgkmcnt(0)\n\ts_barrier" ::: "memory")

constexpr int BATCH = 8, SEQ = 4096, DM = 1024, NTOK = BATCH * SEQ;
constexpr int INC = 2816;
constexpr int C_AQ = 0, C_AK = 512, C_AV = 640, C_HQ = 768, C_HF = 1280, C_HI = 1792, C_HG = 2304;
constexpr int NEXP = 32, TOPK = 4, DFF = 1024;
constexpr float EPS = 1e-5f;
constexpr int LIST_CAP = NTOK;
constexpr int MAX_MT = (NTOK * TOPK) / 256 + NEXP;

constexpr size_t MiB = 1u << 20;
constexpr size_t WS_CTL = 0, CTL_ZERO_BYTES = 64 * 1024;
constexpr size_t WS_MOD = 1 * MiB;
constexpr size_t WS_WRF = 1 * MiB + 512 * 1024;
constexpr size_t WS_SHW = 1 * MiB + 256 * 1024;
constexpr size_t WS_SSQP = 928 * MiB;
constexpr size_t WS_TKE = 2 * MiB, WS_TKW = 2 * MiB + 512 * 1024;
constexpr size_t WS_RNK = 3 * MiB;
constexpr size_t WS_LIST = 4 * MiB;
constexpr size_t WS_WIN = 8 * MiB, WS_WOUT = 14 * MiB;
constexpr size_t WS_WGU = 16 * MiB, WS_WD = 144 * MiB;
constexpr size_t WS_H = 208 * MiB;
constexpr size_t WS_XM = 272 * MiB;
constexpr size_t WS_PROJ = 400 * MiB, WS_MIX = 576 * MiB;
constexpr size_t WS_Y = 400 * MiB;
constexpr size_t WS_ACT = 656 * MiB;
constexpr size_t WS_TSEG = 656 * MiB, WS_DSEG = 672 * MiB;
constexpr size_t WS_END = 930 * MiB;
static_assert(WS_ACT + (size_t)MAX_MT * 256 * 1024 * 2 <= WS_END, "ws map");
constexpr int CW_TMO = 0, CW_CODE = 1, CW_BAR = 4096, CW_CNT = 8192;

constexpr int LDS_BYTES = 147456;
constexpr int LDSCTL_OFF = LDS_BYTES - 4096;
constexpr int L_BARW = LDSCTL_OFF;
constexpr int L_TB = LDSCTL_OFF + 64;
constexpr int L_CN = LDSCTL_OFF + 256;
constexpr int L_HIST = LDSCTL_OFF + 512;
constexpr int L_BASE = LDSCTL_OFF + 640;
constexpr int L_TE = LDSCTL_OFF + 1024;

__device__ __forceinline__ unsigned f2bf(float f) { unsigned u = __builtin_bit_cast(unsigned, f); return (u + 0x7fffu + ((u >> 16) & 1u)) >> 16; }
__device__ __forceinline__ unsigned pk2(float lo, float hi) { return f2bf(lo) | (f2bf(hi) << 16); }
__device__ __forceinline__ float bf2f(unsigned b) { return __builtin_bit_cast(float, b << 16); }
typedef __bf16 bf16x2_t __attribute__((ext_vector_type(2)));
__device__ __forceinline__ unsigned cvtpk(float lo, float hi) { f32x2 v = {lo, hi}; bf16x2_t b = __builtin_convertvector(v, bf16x2_t); return __builtin_bit_cast(unsigned, b); }
__device__ __forceinline__ float bflo(unsigned w) { return __builtin_bit_cast(float, w << 16); }
__device__ __forceinline__ float bfhi(unsigned w) { return __builtin_bit_cast(float, w & 0xffff0000u); }
__device__ __forceinline__ float sigmoidf_(float x) { return __builtin_amdgcn_rcpf(1.f + __expf(-x)); }
typedef int v8i __attribute__((ext_vector_type(8)));
typedef int v6i __attribute__((ext_vector_type(6)));
typedef int v2i_ __attribute__((ext_vector_type(2)));
typedef float f32x16_ __attribute__((ext_vector_type(16)));
typedef unsigned v6u __attribute__((ext_vector_type(6)));
typedef int v4i __attribute__((ext_vector_type(4)));
__device__ __forceinline__ float clamp448(float x) { return __builtin_amdgcn_fmed3f(x, -448.f, 448.f); }
__device__ __forceinline__ unsigned pk4_fp8(float a, float b, float c, float d) {
    int w = 0; w = __builtin_amdgcn_cvt_pk_fp8_f32(clamp448(a), clamp448(b), w, false); w = __builtin_amdgcn_cvt_pk_fp8_f32(clamp448(c), clamp448(d), w, true); return (unsigned)w; }
constexpr bool OUTPROJ_FP8 = true;
constexpr bool MOE1_FP6 = true;
constexpr float SC_H6 = 1.f, SC_W6 = 64.f;
constexpr float SC_H = 8.f, SC_W = 256.f, SC_ACT = 4.f, SC_Y = 16.f, SC_MIX = 16.f, SC_WO = 256.f;
__device__ __forceinline__ float wave_sum(float v) {
#pragma unroll
    for (int o = 1; o < 64; o <<= 1) v += __shfl_xor(v, o);
    return v;
}
__device__ __forceinline__ v6u pk32_fp6(const f32x16_ lo, const f32x16_ hi) { return __builtin_amdgcn_cvt_scalef32_2xpk16_fp6_f32(lo, hi, 1.0f); }


namespace pg8 {
constexpr int BM = 256, BK = 64, HALF = 128, HTB = HALF * BK * 2, STAGE_BYTES = 8 * HTB, NXCD = 8, WGM = 8;
__host__ __device__ __forceinline__ int lds_byte(int r, int c) { const int st = (r >> 4) * 2 + (c >> 5), rr = r & 15, cc = c & 31, ob = rr * 64 + cc * 2; return st * 1024 + (ob ^ (((ob >> 9) & 1) << 5)); }
__host__ __device__ __forceinline__ void stage_rc(int b, int& R, int& C) { const int st = b / 1024, sb = b % 1024, swz = sb ^ (((sb >> 9) & 1) << 5); R = (st >> 1) * 16 + swz / 64; C = (st & 1) * 32 + (swz % 64) / 2; }
__host__ __device__ __forceinline__ int perm32(int rho) { const int n = rho >> 4, i = rho & 15; return 8 * (i >> 2) + 4 * n + (i & 3); }

struct Unit { int pm, pn, e, lt, nv; };
struct Gemm { const bf16* A; const bf16* Bt; int M, N, K; size_t bstride; const int* rowlist; };

struct StaticOrder {
    int nM, nN, nwg, G, c;
    __host__ __device__ void init(int M, int N, int G_, int c_) { nM = M / BM; nN = N / BM; nwg = nM * nN; G = G_; c = c_; }
    __host__ __device__ bool next(int i, Unit& u) const {
        const long L = (long)i * G + c; if (L >= nwg) return false;
        int wgid = (int)L; { const int q = nwg / NXCD, r = nwg % NXCD, xcd = wgid % NXCD, off = wgid / NXCD; wgid = (xcd < r ? xcd * (q + 1) : r * (q + 1) + (xcd - r) * q) + off; }
        const int nig = WGM * nN, gid = wgid / nig, fm = gid * WGM, gsz = (nM - fm) < WGM ? (nM - fm) : WGM;
        u.pm = fm + ((wgid % nig) % gsz); u.pn = (wgid % nig) / gsz; u.e = 0; u.lt = 0; u.nv = 256; return true;
    }
};
struct MoeOrder {
    const LAS int* tb; const LAS int* cn; const LAS int* te; int NP, G, vc, ntiles; bool rev = false;
    __device__ __forceinline__ int chunk_tiles() const { return (ntiles + 7) / 8; }
    __device__ __forceinline__ int xcd_units(int x) const { const int Ct = chunk_tiles(); int t = ntiles - x * Ct; t = t < 0 ? 0 : (t > Ct ? Ct : t); return t * NP; }
    __device__ __forceinline__ bool next(int i, Unit& u) const {
        int T, pn;
        if (G % 8 == 0) { const int R = G / 8, x = vc / R, j = vc % R; const int off = i * R + j; const int xu = xcd_units(x); if (off >= xu) return false; const int tl = off / NP; T = x * chunk_tiles() + (rev ? xu / NP - 1 - tl : tl); pn = off % NP; }
        else { const long L = (long)i * G + vc; if (L >= (long)ntiles * NP) return false; T = (int)(L / NP); if (rev) T = ntiles - 1 - T; pn = (int)(L % NP); }
        const int e = te[T];
        const int mt = T - tb[e]; int nv = cn[e] - mt * 256; nv = nv > 256 ? 256 : nv;
        u.pm = __builtin_amdgcn_readfirstlane(T); u.pn = __builtin_amdgcn_readfirstlane(pn); u.e = __builtin_amdgcn_readfirstlane(e);
        u.lt = __builtin_amdgcn_readfirstlane(e * LIST_CAP + mt * 256); u.nv = __builtin_amdgcn_readfirstlane(nv); return true;
    }
    __device__ __forceinline__ int idle_in_last_round(int* rank) const {
        *rank = -1;
        if (G % 8 != 0) { const long U = (long)ntiles * NP; const int nr = (int)((U + G - 1) / G); const int idle = (int)((long)nr * G - U); if (vc >= G - idle) *rank = vc - (G - idle); return idle; }
        const int R = G / 8, x = vc / R, j = vc % R; const int nr = (xcd_units(0) + R - 1) / R; int total = 0;
        for (int xx = 0; xx < 8; ++xx) { int busy = xcd_units(xx) - (nr - 1) * R; busy = busy < 0 ? 0 : (busy > R ? R : busy);
            if (xx == x && j >= busy) *rank = total + (j - busy);
            total += R - busy; }
        return total;
    }
};

__device__ __forceinline__ unsigned cvt_pk_bf16(float lo, float hi) { unsigned r; asm volatile("v_cvt_pk_bf16_f32 %0, %1, %2" : "=v"(r) : "v"(lo), "v"(hi)); return r; }

struct EpiProj {
    static constexpr bool PERM = true, SLOTS = false;
    bf16* O; const float* bias; const float* hglb; float s;
    __device__ __forceinline__ void operator()(const f32x4 (&acc)[2][2][4][2], const Unit& u, int wr, int wc, int fr, int fq) const {
        const int row0 = u.pm * BM + wr * 64 + fr, col0 = u.pn * BM + wc * 32 + 8 * fq;
        const int mode = (u.pn == 3 || u.pn == 4 || u.pn == 9 || u.pn == 10) ? 1 : ((u.pn == 5 || u.pn == 6) ? 2 : 0);
        f32x4 bv[2][2], ol[2][2];
#pragma unroll
        for (int bj = 0; bj < 2; ++bj)
#pragma unroll
            for (int n = 0; n < 2; ++n) { bv[bj][n] = *(const f32x4*)(bias + col0 + bj * HALF + 4 * n); ol[bj][n] = (f32x4){1.f, 1.f, 1.f, 1.f}; }
        if (mode == 2) { f32x4 a0[2][2], a1[2][2];
#pragma unroll
            for (int bj = 0; bj < 2; ++bj)
#pragma unroll
                for (int n = 0; n < 2; ++n) { const int c = col0 + bj * HALF + 4 * n - 1280; a0[bj][n] = *(const f32x4*)(hglb + c); a1[bj][n] = *(const f32x4*)(hglb + 512 + c); }
#pragma unroll
            for (int bj = 0; bj < 2; ++bj)
#pragma unroll
                for (int n = 0; n < 2; ++n)
#pragma unroll
                    for (int e = 0; e < 4; ++e) ol[bj][n][e] = 1.f - __builtin_amdgcn_rcpf(1.f + __expf(a1[bj][n][e] - a0[bj][n][e])); }
#pragma unroll
        for (int ai = 0; ai < 2; ++ai)
#pragma unroll
            for (int m = 0; m < 4; ++m) { bf16* rowp = O + (size_t)(row0 + ai * HALF + m * 16) * 2816 + col0;
#pragma unroll
                for (int bj = 0; bj < 2; ++bj) { f32x4 v0 = acc[ai][bj][m][0] * s + bv[bj][0], v1 = acc[ai][bj][m][1] * s + bv[bj][1];
                    if (mode == 1) {
#pragma unroll
                        for (int e = 0; e < 4; ++e) { v0[e] = v0[e] * __builtin_amdgcn_rcpf(1.f + __expf(-v0[e])); v1[e] = v1[e] * __builtin_amdgcn_rcpf(1.f + __expf(-v1[e])); } }
                    else if (mode == 2) {
#pragma unroll
                        for (int e = 0; e < 4; ++e) { v0[e] = ol[bj][0][e] * __builtin_amdgcn_rcpf(1.f + __expf(v0[e])); v1[e] = ol[bj][1][e] * __builtin_amdgcn_rcpf(1.f + __expf(v1[e])); } }
                    v4u w; w.x = cvt_pk_bf16(v0[0], v0[1]); w.y = cvt_pk_bf16(v0[2], v0[3]); w.z = cvt_pk_bf16(v1[0], v1[1]); w.w = cvt_pk_bf16(v1[2], v1[3]);
                    *(v4u*)(rowp + bj * HALF) = w; } }
    }
};
struct EpiRes {
    static constexpr bool PERM = true, SLOTS = false;
    bf16* O; const float* X; const float* bias; const float* mod; float* SSQ; float s;
    static __device__ __forceinline__ void swap32(f32x4& a, f32x4& b) {
#pragma unroll
        for (int e = 0; e < 4; ++e) { auto rr = __builtin_amdgcn_permlane32_swap(__float_as_uint(a[e]), __float_as_uint(b[e]), false, false); a[e] = __uint_as_float(rr[0]); b[e] = __uint_as_float(rr[1]); }
    }
    __device__ __forceinline__ void operator()(const f32x4 (&acc)[2][2][4][2], const Unit& u, int wr, int wc, int fr, int fq) const {
        const int row0 = u.pm * BM + wr * 64 + fr, col0 = u.pn * BM + wc * 32 + 8 * fq; const int b = (u.pm * BM) >> 12;
        const int colp = u.pn * BM + wc * 32 + (fq & 1) * 8 + (fq >> 1) * 4;
        f32x4 bv[2][2], gv[2][2];
#pragma unroll
        for (int bj = 0; bj < 2; ++bj)
#pragma unroll
            for (int n = 0; n < 2; ++n) { bv[bj][n] = *(const f32x4*)(bias + col0 + bj * HALF + 4 * n); gv[bj][n] = *(const f32x4*)(mod + b * 6144 + 2048 + col0 + bj * HALF + 4 * n); }
#pragma unroll
        for (int ai = 0; ai < 2; ++ai)
#pragma unroll
            for (int mp = 0; mp < 2; ++mp) {
                f32x4 xv[2][2][2];
#pragma unroll
                for (int mm = 0; mm < 2; ++mm) { const size_t ro = (size_t)(row0 + ai * HALF + (2 * mp + mm) * 16) * DM + colp;
#pragma unroll
                    for (int bj = 0; bj < 2; ++bj)
#pragma unroll
                        for (int n = 0; n < 2; ++n) xv[mm][bj][n] = *(const f32x4*)(X + ro + bj * HALF + 16 * n); }
#pragma unroll
                for (int mm = 0; mm < 2; ++mm) { const int m = 2 * mp + mm; const int row = row0 + ai * HALF + m * 16; const size_t ro = (size_t)row * DM + col0; float ss = 0.f;
#pragma unroll
                    for (int bj = 0; bj < 2; ++bj) { swap32(xv[mm][bj][0], xv[mm][bj][1]); f32x4 ov[2];
#pragma unroll
                        for (int n = 0; n < 2; ++n) { ov[n] = xv[mm][bj][n] + gv[bj][n] * (acc[ai][bj][m][n] * s + bv[bj][n]);
                            ss += (ov[n][0] * ov[n][0] + ov[n][1] * ov[n][1]) + (ov[n][2] * ov[n][2] + ov[n][3] * ov[n][3]); }
                        const v4u w = {cvtpk(ov[0][0], ov[0][1]), cvtpk(ov[0][2], ov[0][3]), cvtpk(ov[1][0], ov[1][1]), cvtpk(ov[1][2], ov[1][3])};
                        *(v4u*)(O + ro + bj * HALF) = w; }
                    ss += __shfl_xor(ss, 16); ss += __shfl_xor(ss, 32);
                    if (fq == 0) SSQ[(size_t)row * 16 + u.pn * 4 + wc] = ss; }
            }
    }
};
struct EpiSwiglu {
    static constexpr bool PERM = true, SLOTS = false;
    unsigned char* O; const float* bgu; float s;
    __device__ __forceinline__ void operator()(const f32x4 (&acc)[2][2][4][2], const Unit& u, int wr, int wc, int fr, int fq) const {
        const int row0 = u.pm * BM + wr * 64 + fr, colo = u.pn * HALF + wc * 32 + 8 * fq;
        const float* bp = bgu + (size_t)u.e * 2048 + 2 * colo;
        f32x4 t[4];
#pragma unroll
        for (int i = 0; i < 4; ++i) t[i] = *(const f32x4*)(bp + 4 * i);
        const f32x4 bg0 = {t[0][0], t[0][2], t[1][0], t[1][2]}, bu0 = {t[0][1], t[0][3], t[1][1], t[1][3]};
        const f32x4 bg1 = {t[2][0], t[2][2], t[3][0], t[3][2]}, bu1 = {t[2][1], t[2][3], t[3][1], t[3][3]};
#pragma unroll
        for (int ai = 0; ai < 2; ++ai)
#pragma unroll
            for (int m = 0; m < 4; ++m) {
                unsigned wq[2];
#pragma unroll
                for (int n = 0; n < 2; ++n) { f32x4 g4 = acc[ai][0][m][n] * s + (n ? bg1 : bg0), u4 = acc[ai][1][m][n] * s + (n ? bu1 : bu0);
                    g4 = __builtin_elementwise_min(g4, (f32x4){7.f, 7.f, 7.f, 7.f}); u4 = __builtin_elementwise_min(__builtin_elementwise_max(u4, (f32x4){-7.f, -7.f, -7.f, -7.f}), (f32x4){7.f, 7.f, 7.f, 7.f});
                    const f32x4 z = g4 * (-1.702f * 1.4426950408889634f); f32x4 sg;
#pragma unroll
                    for (int i = 0; i < 4; ++i) sg[i] = __builtin_amdgcn_rcpf(1.f + __builtin_amdgcn_exp2f(z[i]));
                    const f32x4 a = (u4 + 1.f) * (g4 * SC_ACT) * sg;
                    int w = 0; w = __builtin_amdgcn_cvt_pk_fp8_f32(a[0], a[1], w, false); w = __builtin_amdgcn_cvt_pk_fp8_f32(a[2], a[3], w, true); wq[n] = (unsigned)w; }
                v2u w; w.x = wq[0]; w.y = wq[1];
                *(v2u*)(O + (size_t)(row0 + ai * HALF + m * 16) * DFF + colo) = w; }
    }
};
struct EpiScatter {
    static constexpr bool PERM = true, SLOTS = false;
    unsigned char* O; float s; const float* bd;
    __device__ __forceinline__ void operator()(const f32x4 (&acc)[2][2][4][2], const Unit& u, int wr, int wc, int fr, int fq) const {
        const int row0 = u.pm * BM + wr * 64 + fr, col0 = u.pn * BM + wc * 32 + 8 * fq;
        f32x4 bv[2][2];
#pragma unroll
        for (int bj = 0; bj < 2; ++bj)
#pragma unroll
            for (int n = 0; n < 2; ++n) bv[bj][n] = *(const f32x4*)(bd + (size_t)u.e * DM + col0 + bj * HALF + 4 * n) * SC_Y;
#pragma unroll
        for (int ai = 0; ai < 2; ++ai)
#pragma unroll
            for (int m = 0; m < 4; ++m) { unsigned char* rowp = O + (size_t)(row0 + ai * HALF + m * 16) * DM + col0;
#pragma unroll
                for (int bj = 0; bj < 2; ++bj) { const f32x4 v0 = acc[ai][bj][m][0] * s + bv[bj][0], v1 = acc[ai][bj][m][1] * s + bv[bj][1];
                    v2u w; w.x = pk4_fp8(v0[0], v0[1], v0[2], v0[3]); w.y = pk4_fp8(v1[0], v1[1], v1[2], v1[3]);
                    *(v2u*)(rowp + bj * HALF) = w; } }
    }
};

template <bool FP6> struct FragT { typedef v8i type; };
template <> struct FragT<true> { typedef v6i type; };
template <bool FP6> __device__ __forceinline__ typename FragT<FP6>::type ld_frag(const LAS unsigned char* p) {
    if constexpr (FP6) { const v4i a = *(const LAS v4i*)p; const v2i_ b = *(const volatile LAS v2i_*)(p + 1024);        return (v6i){a[0], a[1], a[2], a[3], b[0], b[1]}; }
    else return __builtin_shufflevector(*(const LAS v4i*)p, *(const LAS v4i*)(p + 1024), 0, 1, 2, 3, 4, 5, 6, 7);
}
template <class Epi, class Sched, bool ALIGN_EPI, bool GATHER, bool FP8 = false, bool FP6 = false>
__device__ __forceinline__ void gemm_phase(LAS unsigned char* lds, const Gemm g, const Sched& S, const Epi& E) {
    const int tid = threadIdx.x, wid = __builtin_amdgcn_readfirstlane(tid >> 6), lane = tid & 63, wr = wid >> 2, wc = wid & 3, fr = lane & 15, fq = lane >> 4;
    const int K = g.K, nt = K / BK;
    unsigned voffA[2], voffB[2]; int RA[2], CA[2];
#pragma unroll
    for (int i = 0; i < 2; ++i) { int R, C; stage_rc(tid * 16 + i * 8192, R, C); const int Rb = Epi::PERM ? ((R & ~31) + perm32(R & 31)) : R;
        RA[i] = R; CA[i] = C; voffA[i] = (unsigned)(R * K + C) * 2u; voffB[i] = (unsigned)(Rb * K + C) * 2u; }
    const size_t kstep = (size_t)(BK * 2);
    const size_t hstep = (size_t)HALF * K * 2;
    const size_t tstep = 2 * hstep;
    const unsigned ldsw = (unsigned)wid * 1024u;
    const int aoff = lds_byte(wr * 64 + fr, fq * 8), boff = lds_byte(wc * 32 + fr, fq * 8);
#define PG8_SA(b, h) (((b) * 2 + (h)) * HTB)
#define PG8_SB(b, h) ((4 + (b) * 2 + (h)) * HTB)
#define PG8_STAGE(bufoff, gbase, voff) do { _Pragma("unroll") for (int _i = 0; _i < 2; ++_i) \
        __builtin_amdgcn_global_load_lds((const unsigned*)((const char*)(gbase) + (voff)[_i]), (LAS unsigned*)(lds + (bufoff) + ldsw + _i * 8192), 16, 0, 0); } while (0)
#define PG8_STAGE_A(bufoff, kptr, h, VV, UU) do { if constexpr (GATHER) PG8_STAGE(bufoff, kptr, VV[h]); else PG8_STAGE(bufoff, (kptr) + (UU) + (size_t)(h) * hstep, voffA); } while (0)
#define PG8_LD8(p) ld_frag<FP6>(p)
#define PG8_LDA(dst, b, h) do { _Pragma("unroll") for (int m = 0; m < 4; ++m) { if constexpr (FP8) dst##8[m] = PG8_LD8(lds + PG8_SA(b, h) + aoff + m * 2048); \
        else { _Pragma("unroll") for (int k = 0; k < 2; ++k) dst[m][k] = *(const LAS bf16x8*)(lds + PG8_SA(b, h) + aoff + m * 2048 + k * 1024); } } } while (0)
#define PG8_LDB(dst, b, h) do { _Pragma("unroll") for (int n = 0; n < 2; ++n) { if constexpr (FP8) dst##8[n] = PG8_LD8(lds + PG8_SB(b, h) + boff + n * 2048); \
        else { _Pragma("unroll") for (int k = 0; k < 2; ++k) dst[n][k] = *(const LAS bf16x8*)(lds + PG8_SB(b, h) + boff + n * 2048 + k * 1024); } } } while (0)
#define PG8_MMA(ai, bj, At, Bt) do { __builtin_amdgcn_s_setprio(1); _Pragma("unroll") for (int m = 0; m < 4; ++m) _Pragma("unroll") for (int n = 0; n < 2; ++n) { \
        if constexpr (FP6) asm volatile("v_mfma_scale_f32_16x16x128_f8f6f4 %0, %1, %2, %0, %3, %3 op_sel_hi:[0,0,0] cbsz:2 blgp:2" : "+v"(acc[ai][bj][m][n]) : "v"(Bt##8[n]), "v"(At##8[m]), "v"(sc1)); \
        else if constexpr (FP8) asm volatile("v_mfma_scale_f32_16x16x128_f8f6f4 %0, %1, %2, %0, %3, %3 op_sel_hi:[0,0,0]" : "+v"(acc[ai][bj][m][n]) : "v"(Bt##8[n]), "v"(At##8[m]), "v"(sc1)); \
        else { _Pragma("unroll") for (int k = 0; k < 2; ++k) acc[ai][bj][m][n] = __builtin_amdgcn_mfma_f32_16x16x32_bf16(Bt[n][k], At[m][k], acc[ai][bj][m][n], 0, 0, 0); } } __builtin_amdgcn_s_setprio(0); } while (0)
#define PG8_WAIT_V(n) asm volatile("s_waitcnt vmcnt(" #n ")" ::: "memory")
#define PG8_WAIT_L(n) asm volatile("s_waitcnt lgkmcnt(" #n ")" ::: "memory")
#define PG8_BAR __builtin_amdgcn_s_barrier()
#define PG8_SCHED __builtin_amdgcn_sched_barrier(0)
#define PG8_AOFFS(v, u) do { _Pragma("unroll") for (int _h = 0; _h < 2; ++_h) _Pragma("unroll") for (int _i = 0; _i < 2; ++_i) { \
        if (GATHER) { const int _r = _h * HALF + RA[_i]; const int _row = g.rowlist[(u).lt + (_r < (u).nv ? _r : 0)] >> 2; v[_h][_i] = (unsigned)(_row * K + CA[_i]) * 2u; } \
        else v[_h][_i] = 0u; } } while (0)
    Unit cur, nxt, nn; int ui = 0;
    if (!S.next(0, cur)) return;
    bool has_next = S.next(1, nxt);
    f32x4 acc[2][2][4][2];
#pragma unroll
    for (int a = 0; a < 2; ++a)
#pragma unroll
        for (int b = 0; b < 2; ++b)
#pragma unroll
            for (int m = 0; m < 4; ++m)
#pragma unroll
                for (int n = 0; n < 2; ++n) acc[a][b][m][n] = (f32x4){0.f, 0.f, 0.f, 0.f};
    bf16x8 At[4][2], B0[2][2], B1[2][2]; typename FragT<FP6>::type At8[4], B08[2], B18[2]; const int sc1 = 0x7f7f7f7f;
    unsigned vC[2][2], vN[2][2]; int slot[8];
    PG8_AOFFS(vC, cur);
    if (has_next) { PG8_AOFFS(vN, nxt); } else {
#pragma unroll
        for (int h = 0; h < 2; ++h)
#pragma unroll
            for (int i = 0; i < 2; ++i) vN[h][i] = vC[h][i]; }
    const char* const Ab = (const char*)g.A;
    size_t uC = (size_t)cur.pm * tstep, uN = has_next ? (size_t)nxt.pm * tstep : uC;
    const char* cB = (const char*)g.Bt + ((size_t)cur.e * g.bstride) * 2 + (size_t)cur.pn * tstep;
    PG8_STAGE(PG8_SB(0, 0), cB, voffB); PG8_STAGE(PG8_SB(0, 1), cB + hstep, voffB); PG8_STAGE_A(PG8_SA(0, 0), Ab, 0, vC, uC); PG8_STAGE_A(PG8_SA(0, 1), Ab, 1, vC, uC);
    if (wr == 1) PG8_BAR;
    PG8_WAIT_V(2); PG8_BAR;
    PG8_STAGE(PG8_SB(1, 0), cB + kstep, voffB); PG8_STAGE_A(PG8_SA(1, 0), Ab + kstep, 0, vC, uC); PG8_STAGE(PG8_SB(1, 1), cB + hstep + kstep, voffB);
    PG8_WAIT_V(6); PG8_BAR;
    for (;;) {
        const bool has_nn = has_next && S.next(ui + 2, nn);
        int rNN[2][2];
#pragma unroll
        for (int h = 0; h < 2; ++h)
#pragma unroll
            for (int i = 0; i < 2; ++i) { rNN[h][i] = 0; if (GATHER) { const int lt_ = has_nn ? nn.lt : cur.lt, nv_ = has_nn ? nn.nv : cur.nv; const int r = h * HALF + RA[i]; rNN[h][i] = g.rowlist[lt_ + (r < nv_ ? r : 0)]; } }
        if constexpr (Epi::SLOTS) E.prefetch(slot, cur, wr, fr);
        const char* nB = has_next ? (const char*)g.Bt + ((size_t)nxt.e * g.bstride) * 2 + (size_t)nxt.pn * tstep : cB;
        for (int t = 0; t < nt; t += 2) {
            const bool last = (t == nt - 2);
            const char* a1 = Ab + (size_t)(t + 1) * kstep;
            const char* a2 = last ? Ab : Ab + (size_t)(t + 2) * kstep; const char* b2 = last ? nB : cB + (size_t)(t + 2) * kstep;
            const char* a3 = a2 + kstep; const char* b3 = b2 + kstep;
            unsigned v2[2][2]; const size_t u2 = last ? uN : uC;
#pragma unroll
            for (int h = 0; h < 2; ++h)
#pragma unroll
                for (int i = 0; i < 2; ++i) v2[h][i] = last ? vN[h][i] : vC[h][i];
            PG8_LDB(B0, 0, 0); PG8_LDB(B1, 0, 1); PG8_SCHED; PG8_LDA(At, 0, 0); PG8_STAGE_A(PG8_SA(1, 1), a1, 1, vC, uC);
            PG8_WAIT_V(8); PG8_WAIT_L(0); PG8_BAR; PG8_MMA(0, 0, At, B0); PG8_MMA(0, 1, At, B1); PG8_BAR; PG8_SCHED;
            PG8_LDA(At, 0, 1); PG8_STAGE(PG8_SB(0, 0), b2, voffB); PG8_STAGE(PG8_SB(0, 1), b2 + hstep, voffB); PG8_STAGE_A(PG8_SA(0, 0), a2, 0, v2, u2);
            PG8_WAIT_V(8); PG8_WAIT_L(0); PG8_BAR; PG8_MMA(1, 0, At, B0); PG8_MMA(1, 1, At, B1); PG8_BAR; PG8_SCHED;
            PG8_LDB(B0, 1, 0); PG8_LDB(B1, 1, 1); PG8_SCHED; PG8_LDA(At, 1, 0); PG8_STAGE_A(PG8_SA(0, 1), a2, 1, v2, u2);
            PG8_WAIT_V(8); PG8_WAIT_L(0); PG8_BAR; PG8_MMA(0, 0, At, B0); PG8_MMA(0, 1, At, B1); PG8_BAR; PG8_SCHED;
            PG8_LDA(At, 1, 1); PG8_STAGE(PG8_SB(1, 0), b3, voffB); PG8_STAGE(PG8_SB(1, 1), b3 + hstep, voffB); PG8_STAGE_A(PG8_SA(1, 0), a3, 0, v2, u2);
            PG8_WAIT_V(8); PG8_WAIT_L(0); PG8_BAR; PG8_MMA(1, 0, At, B0); PG8_MMA(1, 1, At, B1); PG8_BAR; PG8_SCHED;
        }
        if constexpr (ALIGN_EPI) { if (wr == 0) PG8_BAR; }
        if constexpr (FP8) asm volatile("s_nop 15\n\ts_nop 15" ::: "memory");
        if constexpr (Epi::SLOTS) E(acc, cur, wr, wc, fr, fq, slot); else E(acc, cur, wr, wc, fr, fq);
        if (!has_next) break;
#pragma unroll
        for (int a = 0; a < 2; ++a)
#pragma unroll
            for (int b = 0; b < 2; ++b)
#pragma unroll
                for (int m = 0; m < 4; ++m)
#pragma unroll
                    for (int n = 0; n < 2; ++n) acc[a][b][m][n] = (f32x4){0.f, 0.f, 0.f, 0.f};
        cur = nxt; nxt = nn; has_next = has_nn; cB = nB; ++ui; uC = uN; if (has_next) uN = (size_t)nxt.pm * tstep;
#pragma unroll
        for (int h = 0; h < 2; ++h)
#pragma unroll
            for (int i = 0; i < 2; ++i) { vC[h][i] = vN[h][i]; if (GATHER) asm volatile("" : "+v"(rNN[h][i]));
                if (GATHER && has_next) vN[h][i] = (unsigned)((rNN[h][i] >> 2) * K + CA[i]) * 2u; }
        if constexpr (ALIGN_EPI) { if (wr == 1) PG8_BAR; }
    }
    PG8_WAIT_V(0);
    if constexpr (!ALIGN_EPI) { if (wr == 0) PG8_BAR; }
    PG8_BAR;
#undef PG8_SA
#undef PG8_SB
#undef PG8_STAGE
#undef PG8_LDA
#undef PG8_LDB
#undef PG8_MMA
#undef PG8_LD8
#undef PG8_STAGE_A
#undef PG8_WAIT_V
#undef PG8_WAIT_L
#undef PG8_BAR
#undef PG8_SCHED
#undef PG8_AOFFS
}
}

#define XB_TMO      128
#define XB_XCNT(j)  (256  + 64 * (j))
#define XB_XSUB(j)  (1280 + 64 * (j))
#define XB_XGEN(j)  (2304 + 64 * (j))
#define XB_TOP      3328
#define XB_TOPGEN   3392
#define XCD_BAR_WORDS 3456
#define XB_SPIN_CAP (1u << 22)
__device__ __forceinline__ unsigned xb_ld(unsigned* p)              { return __hip_atomic_load(p, __ATOMIC_RELAXED, __HIP_MEMORY_SCOPE_AGENT); }
__device__ __forceinline__ unsigned xb_add(unsigned* p, unsigned v) { return __hip_atomic_fetch_add(p, v, __ATOMIC_RELAXED, __HIP_MEMORY_SCOPE_AGENT); }
__device__ __forceinline__ unsigned xb_xcc_id() { return (unsigned)__builtin_amdgcn_s_getreg((3 << 11) | 20) & 0xFu; }
#define XB_SPIN(cond, bar) do { unsigned _sp = 0; while (cond) { __builtin_amdgcn_s_sleep(1); \
    if ((++_sp & 255u) == 0u) { if (xb_ld(&(bar)[XB_TMO])) break; if (_sp > XB_SPIN_CAP) { atomicAdd(&(bar)[XB_TMO], 1u); break; } } } } while (0)
struct XcdBarrier { unsigned* bar; unsigned x; volatile LAS unsigned* st; };
__device__ __forceinline__ XcdBarrier xcd_barrier_post(unsigned* bar, volatile LAS unsigned* st) {
    XcdBarrier b; b.bar = bar; b.x = xb_xcc_id(); b.st = st;
    if (threadIdx.x == 0) (void)xb_add(&bar[XB_XCNT(b.x)], 1u);
    return b;
}
__device__ __forceinline__ void xcd_barrier_complete(unsigned* bar, unsigned x, unsigned& nloc, unsigned& nx) {
    const unsigned G = gridDim.x * gridDim.y * gridDim.z;
    unsigned sum, cnt, mine, sp = 0u;
    for (;;) {
        sum = 0u; cnt = 0u; mine = 0u;
#pragma unroll
        for (unsigned j = 0; j < 16; ++j) { const unsigned c = xb_ld(&bar[XB_XCNT(j)]); sum += c; cnt += (c > 0u) ? 1u : 0u; mine = (j == x) ? c : mine; }
        if (sum == G) break;
        __builtin_amdgcn_s_sleep(1);
        if ((++sp & 255u) == 0u) { if (xb_ld(&bar[XB_TMO])) break; if (sp > XB_SPIN_CAP) { atomicAdd(&bar[XB_TMO], 1u); break; } }
    }
    nloc = mine > 0u ? mine : 1u; nx = cnt > 0u ? cnt : 1u;
}
__device__ __forceinline__ void xcd_barrier(const XcdBarrier& b) {
    asm volatile("s_waitcnt vmcnt(0)" ::: "memory");
    __syncthreads();
    if (threadIdx.x == 0) {
        unsigned* bar = b.bar;
        __builtin_amdgcn_s_waitcnt(0);
        unsigned nloc = b.st[0], nx = b.st[1];
        if (nloc == 0u) { xcd_barrier_complete(bar, b.x, nloc, nx); b.st[0] = nloc; b.st[1] = nx; }
        const unsigned old = xb_add(&bar[XB_XSUB(b.x)], 1u);
        const unsigned gen = old / nloc;
        if (old + 1u == (gen + 1u) * nloc) {
            __builtin_amdgcn_fence(__ATOMIC_RELEASE, "agent");
            asm volatile("s_waitcnt vmcnt(0)" ::: "memory");
            const unsigned og = xb_add(&bar[XB_TOP], 1u);
            const unsigned tg = og / nx;
            if (og + 1u == (tg + 1u) * nx) xb_add(&bar[XB_TOPGEN], 1u);
            else XB_SPIN(xb_ld(&bar[XB_TOPGEN]) == tg, bar);
            __builtin_amdgcn_fence(__ATOMIC_ACQUIRE, "agent");
            xb_add(&bar[XB_XGEN(b.x)], 1u);
            asm volatile("s_waitcnt vmcnt(0)" ::: "memory");
        } else {
            XB_SPIN(xb_ld(&bar[XB_XGEN(b.x)]) == gen, bar);
            __builtin_amdgcn_fence(__ATOMIC_ACQUIRE, "agent");
            asm volatile("s_waitcnt vmcnt(0)" ::: "memory");
        }
    }
    __syncthreads();
}

struct Args { const float* in[21]; float* out; unsigned char* ws; int ph_lo, ph_hi; };
struct Ctx {
    LAS unsigned char* lds; int tid, lane, wave, vcu, G;
};

template <bool GU>
__device__ __forceinline__ void p0_transpose_item(const float* W, int K, int N, bf16* WT, LAS float* scr, int item, int lane) {
    const int nblk = N / 32, kb = item / nblk, nb = item % nblk, k0 = 64 * kb, n0 = 32 * nb;
    float ld[32];
#pragma unroll
    for (int i = 0; i < 32; ++i) ld[i] = W[(size_t)(k0 + 2 * i + (lane >> 5)) * N + n0 + (lane & 31)];
#pragma unroll
    for (int i = 0; i < 32; ++i) scr[(2 * i + (lane >> 5)) * 33 + (lane & 31)] = ld[i];
    LDS_WAIT(); asm volatile("" ::: "memory");
    const int c = lane & 7;
#pragma unroll
    for (int j = 0; j < 4; ++j) { const int n = (lane >> 3) + 8 * j; const LAS float* s = scr + (8 * c) * 33 + n;
        v4u o; o.x = pk2(s[0 * 33], s[1 * 33]); o.y = pk2(s[2 * 33], s[3 * 33]); o.z = pk2(s[4 * 33], s[5 * 33]); o.w = pk2(s[6 * 33], s[7 * 33]);
        const int col = n0 + n; int row = col;
        if (GU) { const int jj = col >> 1, sg = col & 1; row = (jj >> 7) * 256 + sg * 128 + (jj & 127); }
        *(GAS v4u*)(WT + (size_t)row * K + k0 + 8 * c) = o; }
    LDS_WAIT(); asm volatile("" ::: "memory");
}
template <bool GU>
__device__ __forceinline__ void p0_transpose_item8(const float* W, int K, int N, unsigned char* WT, LAS float* scr, int item, int lane) {
    const int nblk = N / 32, kb = item / nblk, nb = item % nblk, k0 = 128 * kb, n0 = 32 * nb;
#pragma unroll
    for (int hf = 0; hf < 2; ++hf) {
        float ld[32];
#pragma unroll
        for (int i = 0; i < 32; ++i) ld[i] = W[(size_t)(k0 + 64 * hf + 2 * i + (lane >> 5)) * N + n0 + (lane & 31)];
#pragma unroll
        for (int i = 0; i < 32; ++i) scr[(64 * hf + 2 * i + (lane >> 5)) * 33 + (lane & 31)] = ld[i];
    }
    LDS_WAIT(); asm volatile("" ::: "memory");
    const int c = lane & 7;
#pragma unroll
    for (int j = 0; j < 4; ++j) { const int n = (lane >> 3) + 8 * j; const LAS float* s = scr + (16 * c) * 33 + n;
        v4u o;
        o.x = pk4_fp8(s[0 * 33] * SC_W, s[1 * 33] * SC_W, s[2 * 33] * SC_W, s[3 * 33] * SC_W); o.y = pk4_fp8(s[4 * 33] * SC_W, s[5 * 33] * SC_W, s[6 * 33] * SC_W, s[7 * 33] * SC_W);
        o.z = pk4_fp8(s[8 * 33] * SC_W, s[9 * 33] * SC_W, s[10 * 33] * SC_W, s[11 * 33] * SC_W); o.w = pk4_fp8(s[12 * 33] * SC_W, s[13 * 33] * SC_W, s[14 * 33] * SC_W, s[15 * 33] * SC_W);
        const int col = n0 + n; int row = col;
        if (GU) { const int jj = col >> 1, sg = col & 1; row = (jj >> 7) * 256 + sg * 128 + (jj & 127); }
        *(GAS v4u*)(WT + (size_t)row * K + k0 + 16 * c) = o; }
    LDS_WAIT(); asm volatile("" ::: "memory");
}
__device__ __forceinline__ void p0_gu_tile_load(f32x4 (&pre)[8], const float* W, int kb, int nb, int wave, int lane) {
#pragma unroll
    for (int i = 0; i < 8; ++i) pre[i] = *(const f32x4*)(W + (size_t)(128 * kb + 16 * wave + 2 * i + (lane >> 5)) * 2048 + 128 * nb + 4 * (lane & 31));
}
__device__ __forceinline__ void p0_gu_tile_store(const f32x4 (&pre)[8], unsigned char* WT, int kb, int nb, LAS float* scr, int wave, int lane) {
#pragma unroll
    for (int i = 0; i < 8; ++i) { LAS float* d = scr + (16 * wave + 2 * i + (lane >> 5)) * 129 + 4 * (lane & 31); d[0] = pre[i][0]; d[1] = pre[i][1]; d[2] = pre[i][2]; d[3] = pre[i][3]; }
    LDS_BARRIER();
    if constexpr (MOE1_FP6) {
        const int q = lane & 3, n = 16 * wave + (lane >> 2); const LAS float* s = scr + (32 * q) * 129 + n;
        f32x16_ lo, hi;
#pragma unroll
        for (int i = 0; i < 16; ++i) { lo[i] = s[i * 129] * SC_W6; hi[i] = s[(16 + i) * 129] * SC_W6; }
        const v6u o = pk32_fp6(lo, hi);
        const int col = 128 * nb + n, jj = col >> 1, sg = col & 1, row = (jj >> 7) * 256 + sg * 128 + (jj & 127);
        unsigned char* d = WT + (size_t)row * DM + 128 * kb + 16 * q;
        *(GAS v4u*)d = (v4u){o[0], o[1], o[2], o[3]}; *(GAS v2u*)(d + 64) = (v2u){o[4], o[5]};
        LDS_BARRIER(); return; }
    const int c = lane & 7;
#pragma unroll
    for (int j = 0; j < 2; ++j) { const int n = 16 * wave + (lane >> 3) + 8 * j; const LAS float* s = scr + (16 * c) * 129 + n;
        v4u o;
        o.x = pk4_fp8(s[0 * 129] * SC_W, s[1 * 129] * SC_W, s[2 * 129] * SC_W, s[3 * 129] * SC_W); o.y = pk4_fp8(s[4 * 129] * SC_W, s[5 * 129] * SC_W, s[6 * 129] * SC_W, s[7 * 129] * SC_W);
        o.z = pk4_fp8(s[8 * 129] * SC_W, s[9 * 129] * SC_W, s[10 * 129] * SC_W, s[11 * 129] * SC_W); o.w = pk4_fp8(s[12 * 129] * SC_W, s[13 * 129] * SC_W, s[14 * 129] * SC_W, s[15 * 129] * SC_W);
        const int col = 128 * nb + n, jj = col >> 1, sg = col & 1, row = (jj >> 7) * 256 + sg * 128 + (jj & 127);
        *(GAS v4u*)(WT + (size_t)row * DM + 128 * kb + 16 * c) = o; }
    LDS_BARRIER();
}
constexpr int TAIL_EXP = 14, TAIL_B = 9;
__device__ __forceinline__ int inproj_idle_wgs(int G) { const int nwg = (NTOK / 256) * (INC / 256); const int nr = (nwg + G - 1) / G; return nr * G - nwg; }
__device__ __forceinline__ bool tail_enabled(int G) { return inproj_idle_wgs(G) >= 64; }
__device__ __forceinline__ void phase_prologue(const Ctx& F, const Args& A) {
    unsigned char* ws = A.ws;
    {
        LAS float* sck = (LAS float*)F.lds;
        LAS float* part = sck + 8192;
        const float* c = A.in[1]; const float* wada = A.in[2]; const float* bada = A.in[3]; float* mod = (float*)(ws + WS_MOD);
        bool did = false;
        for (int cb = blockIdx.x; cb < 96; cb += F.G) {
            if (!did) { for (int i = F.tid; i < 8192; i += 512) { const int b = i >> 10, k = i & 1023; const float v = c[i]; sck[k * 8 + b] = v * sigmoidf_(v); } did = true; }
            __syncthreads();
            const int n = cb * 64 + F.lane; float acc[8];
#pragma unroll
            for (int b = 0; b < 8; ++b) acc[b] = 0.f;
#pragma unroll 32
            for (int kk = 0; kk < 128; ++kk) { const int k = F.wave * 128 + kk; const float wv = wada[(size_t)k * 6144 + n];
                const f32x4 s0 = *(const LAS f32x4*)(sck + k * 8), s1 = *(const LAS f32x4*)(sck + k * 8 + 4);
                acc[0] += s0[0] * wv; acc[1] += s0[1] * wv; acc[2] += s0[2] * wv; acc[3] += s0[3] * wv; acc[4] += s1[0] * wv; acc[5] += s1[1] * wv; acc[6] += s1[2] * wv; acc[7] += s1[3] * wv; }
#pragma unroll
            for (int b = 0; b < 8; ++b) part[(F.wave * 8 + b) * 64 + F.lane] = acc[b];
            __syncthreads();
            { const int b = F.tid >> 6; float s = 0.f;
#pragma unroll
              for (int w = 0; w < 8; ++w) s += part[(w * 8 + b) * 64 + F.lane];
              mod[b * 6144 + n] = s + bada[n]; }
            __syncthreads();
        }
        __syncthreads();
    }
    {
        const float* wr = A.in[14]; v4u* wrf = (v4u*)(ws + WS_WRF);
        for (int i = blockIdx.x * 512 + F.tid; i < 32 * 2 * 64; i += F.G * 512) {
            const int lane = i & 63, nt = (i >> 6) & 1, s = i >> 7, q = lane >> 4, e = (lane & 15) + 16 * nt;
            float hi[8], lo[8];
#pragma unroll
            for (int j = 0; j < 8; ++j) { const float w = wr[(size_t)(MOE1_FP6 ? 128 * (s >> 2) + 32 * q + 8 * (s & 3) + j : 32 * s + 8 * q + j) * 32 + e];   const float h = bf2f(f2bf(w)); hi[j] = h; lo[j] = w - h; }
            v4u oh, ol; oh.x = pk2(hi[0], hi[1]); oh.y = pk2(hi[2], hi[3]); oh.z = pk2(hi[4], hi[5]); oh.w = pk2(hi[6], hi[7]);
            ol.x = pk2(lo[0], lo[1]); ol.y = pk2(lo[2], lo[3]); ol.z = pk2(lo[4], lo[5]); ol.w = pk2(lo[6], lo[7]);
            wrf[((s * 2 + nt) * 2 + 0) * 64 + lane] = oh; wrf[((s * 2 + nt) * 2 + 1) * 64 + lane] = ol;
        }
    }
    {
        LAS float* scr = (LAS float*)(F.lds + F.wave * 16896);
        const int gw = F.vcu * 8 + F.wave, NGW = F.G * 8;
        constexpr int I_IN = (DM / 128) * (INC / 32), I_OUT = (OUTPROJ_FP8 ? DM / 128 : DM / 64) * (DM / 32), I_GU = (DM / 128) * (2048 / 32), I_D = (DFF / 128) * (DM / 32);
        const int ND = (tail_enabled(F.G) ? NEXP - TAIL_EXP - TAIL_B : NEXP) * I_D, NITEMS = I_IN + I_OUT + ND;
        bf16* win = (bf16*)(ws + WS_WIN); bf16* wout = (bf16*)(ws + WS_WOUT); unsigned char* wgu = ws + WS_WGU; unsigned char* wd = ws + WS_WD;
        for (int it = gw; it < NITEMS; it += NGW) {
            int r = it;
            if (r < I_IN) { p0_transpose_item8<false>(A.in[5], DM, INC, (unsigned char*)win, scr, r, F.lane); continue; } r -= I_IN;
            if (r < I_OUT) { if constexpr (OUTPROJ_FP8) p0_transpose_item8<false>(A.in[11], DM, DM, (unsigned char*)wout, scr, r, F.lane); else p0_transpose_item<false>(A.in[11], DM, DM, wout, scr, r, F.lane); continue; } r -= I_OUT;
            { const int e = r / I_D; p0_transpose_item8<false>(A.in[18] + (size_t)e * DFF * DM, DFF, DM, wd + (size_t)e * DM * DFF, scr, r % I_D, F.lane); }
        }
        __syncthreads();
        {
            constexpr int NT = NEXP * 128; const int nmod = F.G < 96 ? F.G : 96;
            int t0, t1;
            { const int skew = 7; const long tot = (long)NT + (long)skew * nmod; const int per = (int)(tot / F.G), rem = (int)(tot % F.G);
              const int bx = blockIdx.x; const long v0 = (long)bx * per + (bx < rem ? bx : rem), v1 = v0 + per + (bx < rem ? 1 : 0);
              const long done_before = (long)(bx < nmod ? bx : nmod) * skew;
              t0 = (int)(v0 - done_before); t1 = (int)(v1 - done_before - (bx < nmod ? skew : 0)); if (t1 < t0) t1 = t0; if (t1 > NT) t1 = NT; if (t0 > NT) t0 = NT; }
            LAS float* tsc = (LAS float*)F.lds;
            f32x4 pre[8];
            if (t0 < t1) { const int e = t0 >> 7, kb = (t0 >> 4) & 7, nb = t0 & 15; p0_gu_tile_load(pre, A.in[16] + (size_t)e * DM * 2048, kb, nb, F.wave, F.lane); }
            for (int t = t0; t < t1; ++t) {
                const int e = t >> 7, kb = (t >> 4) & 7, nb = t & 15;
                f32x4 cur[8];
#pragma unroll
                for (int i = 0; i < 8; ++i) cur[i] = pre[i];
                if (t + 1 < t1) { const int e2 = (t + 1) >> 7, kb2 = ((t + 1) >> 4) & 7, nb2 = (t + 1) & 15; p0_gu_tile_load(pre, A.in[16] + (size_t)e2 * DM * 2048, kb2, nb2, F.wave, F.lane); }
                p0_gu_tile_store(cur, wgu + (size_t)e * 2048 * DM, kb, nb, tsc, F.wave, F.lane);
            }
        }
    }
}
__device__ __forceinline__ void phase_wd_tail(const Ctx& F, const Args& A) {
    if (!tail_enabled(F.G)) return;
    const int idle = inproj_idle_wgs(F.G), first = F.G - idle;
    if ((int)blockIdx.x < first) return;
    LAS float* scr = (LAS float*)(F.lds + F.wave * 16896);
    constexpr int I_D = (DFF / 128) * (DM / 32);
    unsigned char* wd = A.ws + WS_WD;
    for (int it = ((int)blockIdx.x - first) * 8 + F.wave; it < TAIL_EXP * I_D; it += idle * 8) {
        const int e = NEXP - TAIL_EXP + it / I_D;
        p0_transpose_item8<false>(A.in[18] + (size_t)e * DFF * DM, DFF, DM, wd + (size_t)e * DM * DFF, scr, it % I_D, F.lane);
    }
}

__device__ __forceinline__ void phase_wd_tail2(const Ctx& F, const Args& A, const pg8::MoeOrder& S) {
    if (!tail_enabled(F.G)) return;
    int rank; int idle = S.idle_in_last_round(&rank);
    if (idle < 64) { idle = F.G; rank = F.vcu; }
    if (rank < 0) return;
    LAS float* scr = (LAS float*)(F.lds + F.wave * 16896);
    constexpr int I_D = (DFF / 128) * (DM / 32);
    unsigned char* wd = A.ws + WS_WD;
    for (int it = rank * 8 + F.wave; it < TAIL_B * I_D; it += idle * 8) {
        const int e = NEXP - TAIL_EXP - TAIL_B + it / I_D;
        p0_transpose_item8<false>(A.in[18] + (size_t)e * DFF * DM, DFF, DM, wd + (size_t)e * DM * DFF, scr, it % I_D, F.lane);
    }
}

__device__ __forceinline__ void phase_norm1(const Ctx& F, const Args& A) {
    const float* x = A.in[0]; const float* g = A.in[4]; const float* mod = (const float*)(A.ws + WS_MOD); bf16* H = (bf16*)(A.ws + WS_H);
    const int gw = F.vcu * 8 + F.wave, NGW = F.G * 8;
    for (int m0 = 2 * gw; m0 < NTOK; m0 += 2 * NGW) {
        const int b = m0 >> 12;
        f32x4 v[2][4]; float s[2] = {0.f, 0.f};
#pragma unroll
        for (int r = 0; r < 2; ++r) { const f32x4* xr = (const f32x4*)(x + (size_t)(m0 + r) * DM) + F.lane;
#pragma unroll
            for (int j = 0; j < 4; ++j) v[r][j] = xr[64 * j]; }
#pragma unroll
        for (int r = 0; r < 2; ++r)
#pragma unroll
            for (int j = 0; j < 4; ++j) s[r] += (v[r][j][0] * v[r][j][0] + v[r][j][1] * v[r][j][1]) + (v[r][j][2] * v[r][j][2] + v[r][j][3] * v[r][j][3]);
        const float rstd0 = rsqrtf(wave_sum(s[0]) * (1.f / DM) + EPS), rstd1 = rsqrtf(wave_sum(s[1]) * (1.f / DM) + EPS);
#pragma unroll
        for (int j = 0; j < 4; ++j) { const int c0 = 4 * (F.lane + 64 * j);
            const f32x4 gv = *(const f32x4*)(g + c0), sh = *(const f32x4*)(mod + b * 6144 + c0), sc = *(const f32x4*)(mod + b * 6144 + 1024 + c0);
            const f32x4 gs = gv * (sc + 1.f);
#pragma unroll
            for (int r = 0; r < 2; ++r) { const f32x4 h = (v[r][j] * (r ? rstd1 : rstd0) * gs + sh) * SC_H;
                ((unsigned*)((unsigned char*)H + (size_t)(m0 + r) * DM) + F.lane)[64 * j] = pk4_fp8(h[0], h[1], h[2], h[3]); } }
    }
}


typedef short v4i16_t __attribute__((ext_vector_type(4)));
typedef float f32x16 __attribute__((ext_vector_type(16)));
__device__ __forceinline__ int crow(int r, int hi) { return (r & 3) + 8 * (r >> 2) + 4 * hi; }
constexpr int AT_STR = 144;
__device__ __forceinline__ void phase_attn(const Ctx& F, const Args& A) {
    LAS unsigned char* Kl = F.lds; LAS unsigned char* Vl = F.lds + 256 * AT_STR; LAS float* tab = (LAS float*)(F.lds + 2 * 256 * AT_STR);
    const bf16* PROJ = (const bf16*)(A.ws + WS_PROJ); bf16* MIX = (bf16*)(A.ws + WS_MIX);
    const float* sinks = A.in[7]; const float* relb = A.in[8];
    constexpr float L2E = 1.4426950408889634f;
    for (int i = F.tid; i < 8 * 192; i += 512) { const int h = i / 192, dd = i % 192 - 32; const int n = dd < 0 ? 0 : (dd > 127 ? 127 : dd); int bkt = n;
        if (n >= 16) { const int l = 16 + (int)(logf((float)n / 16.f) / logf(8.f) * 16.f); bkt = l < 31 ? l : 31; }
        tab[i] = relb[bkt * 8 + h] * L2E; }
    const int ql = F.lane & 31, hh = F.lane >> 5, wq = F.wave & 3, r0 = wq * 32;
    const int i16 = F.lane & 15, tq = i16 >> 2, tp = i16 & 3, blk = (F.lane >> 4) & 1;
    v4u kreg[4], vreg[4];
#define AT_LOAD_KV(uu) do { const int kvh_ = (uu) & 1, n_ = ((uu) >> 1) & 31, b_ = (uu) >> 6; _Pragma("unroll") for (int i = 0; i < 4; ++i) { const int id = F.tid + 512 * i, key = id >> 3, c = id & 7, pos = (n_ - 1) * 128 + key; \
        kreg[i] = (v4u){0u, 0u, 0u, 0u}; vreg[i] = (v4u){0u, 0u, 0u, 0u}; \
        if (pos >= 0) { const bf16* src = PROJ + (size_t)(b_ * SEQ + pos) * INC + kvh_ * 64 + c * 8; kreg[i] = *(const v4u*)(src + C_AK); vreg[i] = *(const v4u*)(src + C_AV); } } } while (0)
    if ((int)blockIdx.x < 512) AT_LOAD_KV((int)blockIdx.x);
    for (int u = blockIdx.x; u < 512; u += F.G) {
        const int kvh = u & 1, n = (u >> 1) & 31, b = u >> 6;
        LDS_BARRIER();
#pragma unroll
        for (int i = 0; i < 4; ++i) { const int id = F.tid + 512 * i, key = id >> 3, c = id & 7;
            *(LAS v4u*)(Kl + key * AT_STR + c * 16) = kreg[i]; *(LAS v4u*)(Vl + key * AT_STR + c * 16) = vreg[i]; }
        bf16x8 qf0[4], qf1[4];
        { const size_t tok = (size_t)(b * SEQ + n * 128 + r0 + ql);
          const bf16* q0 = PROJ + tok * INC + C_AQ + (kvh * 4 + (F.wave >> 2)) * 64 + 8 * hh; const bf16* q1 = q0 + 2 * 64;
#pragma unroll
          for (int s = 0; s < 4; ++s) { qf0[s] = *(const bf16x8*)(q0 + 16 * s); qf1[s] = *(const bf16x8*)(q1 + 16 * s); } }
        if (u + F.G < 512) AT_LOAD_KV(u + F.G);
        LDS_BARRIER();
#pragma unroll 1
        for (int p = 0; p < 2; ++p) {
            const int head = kvh * 4 + p * 2 + (F.wave >> 2);
            const size_t tok = (size_t)(b * SEQ + n * 128 + r0 + ql);
            bf16x8 qf[4];
#pragma unroll
            for (int s = 0; s < 4; ++s) qf[s] = p ? qf1[s] : qf0[s];
            f32x16 sacc[5];
            const f32x16 zero16 = {0.f, 0.f, 0.f, 0.f, 0.f, 0.f, 0.f, 0.f, 0.f, 0.f, 0.f, 0.f, 0.f, 0.f, 0.f, 0.f};
#pragma unroll
            for (int kt = 0; kt < 5; ++kt) {
                const LAS unsigned char* kb = Kl + ((wq + kt) * 32 + ql) * AT_STR + 16 * hh;
#pragma unroll
                for (int s = 0; s < 4; ++s) { const bf16x8 kf = *(const LAS bf16x8*)(kb + 32 * s); sacc[kt] = __builtin_amdgcn_mfma_f32_32x32x16_bf16(kf, qf[s], s == 0 ? zero16 : sacc[kt], 0, 0, 0); } }
            const LAS float* tabh = tab + head * 192 + (ql + 160 - 4 * hh);
            const float sk = sinks[head] * L2E;
            float mx = sk;
#pragma unroll
            for (int kt = 0; kt < 5; ++kt) {
                const bool tile_ok = (n > 0) || (wq + kt >= 4);
                if (tile_ok) {
#pragma unroll
                    for (int i = 0; i < 16; ++i) { const int ml = (i & 3) + 8 * (i >> 2) + 4 * hh;
                        float s = sacc[kt][i] * (0.125f * L2E) + tabh[-(32 * kt + 8 * (i >> 2) + (i & 3))];
                        if (kt == 0) s = (ml > ql) ? s : -1e30f;
                        if (kt == 4) s = (ml <= ql) ? s : -1e30f;
                        sacc[kt][i] = s; mx = fmaxf(mx, s); }
                } else {
#pragma unroll
                    for (int i = 0; i < 16; ++i) sacc[kt][i] = -1e30f;
                }
                __builtin_amdgcn_sched_barrier(0);
            }
            mx = fmaxf(mx, __shfl_xor(mx, 32));
            float sum = 0.f;
#pragma unroll
            for (int kt = 0; kt < 5; ++kt)
#pragma unroll
                for (int i = 0; i < 16; ++i) { const float pv = __builtin_amdgcn_exp2f(sacc[kt][i] - mx); sacc[kt][i] = pv; sum += pv; }
            sum += __shfl_xor(sum, 32);
            sum += __builtin_amdgcn_exp2f(sk - mx);
            f32x16 o[2];
#pragma unroll
            for (int kt = 0; kt < 5; ++kt)
#pragma unroll
                for (int s2 = 0; s2 < 2; ++s2) {
                    v4u pw; pw.x = cvtpk(sacc[kt][8 * s2], sacc[kt][8 * s2 + 1]); pw.y = cvtpk(sacc[kt][8 * s2 + 2], sacc[kt][8 * s2 + 3]);
                    pw.z = cvtpk(sacc[kt][8 * s2 + 4], sacc[kt][8 * s2 + 5]); pw.w = cvtpk(sacc[kt][8 * s2 + 6], sacc[kt][8 * s2 + 7]);
                    const bf16x8 pf = __builtin_bit_cast(bf16x8, pw);
                    const LAS unsigned char* vb = Vl + ((wq + kt) * 32 + 16 * s2 + 4 * hh + tq) * AT_STR + 32 * blk + 8 * tp;
#pragma unroll
                    for (int dt = 0; dt < 2; ++dt) {
                        const v4i16_t lo = __builtin_amdgcn_ds_read_tr16_b64_v4i16((LAS v4i16_t*)(vb + dt * 64));
                        const v4i16_t hi = __builtin_amdgcn_ds_read_tr16_b64_v4i16((LAS v4i16_t*)(vb + dt * 64 + 8 * AT_STR));
                        const bf16x8 vf = {lo[0], lo[1], lo[2], lo[3], hi[0], hi[1], hi[2], hi[3]};
                        o[dt] = __builtin_amdgcn_mfma_f32_32x32x16_bf16(vf, pf, (kt == 0 && s2 == 0) ? zero16 : o[dt], 0, 0, 0); } }
            const float inv = (OUTPROJ_FP8 ? SC_MIX : 1.f) / sum;
            bf16* orow = MIX + tok * DM + head * 64 + 4 * hh;
            if constexpr (OUTPROJ_FP8) { unsigned char* orow8 = (unsigned char*)MIX + tok * DM + head * 64 + 4 * hh;
#pragma unroll
                for (int dt = 0; dt < 2; ++dt)
#pragma unroll
                    for (int g = 0; g < 4; ++g) *(unsigned*)(orow8 + dt * 32 + 8 * g) = pk4_fp8(o[dt][4 * g] * inv, o[dt][4 * g + 1] * inv, o[dt][4 * g + 2] * inv, o[dt][4 * g + 3] * inv); }
            else
#pragma unroll
            for (int dt = 0; dt < 2; ++dt)
#pragma unroll
                for (int g = 0; g < 4; ++g) { v2u w; w.x = cvtpk(o[dt][4 * g] * inv, o[dt][4 * g + 1] * inv); w.y = cvtpk(o[dt][4 * g + 2] * inv, o[dt][4 * g + 3] * inv);
                    *(v2u*)(orow + dt * 32 + 8 * g) = w; }
        }
    }
#undef AT_LOAD_KV
    __syncthreads();
}


constexpr int HG_QSTR = 272, HG_TSTR = 80;
constexpr int HB_QP = 0, HB_QI = 8704, HB_KP = 17408, HB_KT = 26112, HB_VT = 36352, HB_D = 46592, HB_SIZE = 47104;
constexpr int HG_SEG = 512, HG_NCH = 16, HG_NSEG = SEQ / HG_SEG;
__device__ __forceinline__ int perm16(int k) { return 8 * ((k >> 2) & 1) + (k & 3) + 4 * (k >> 3); }

template <int PASS>
__device__ __forceinline__ void hg_produce(LAS unsigned char* buf, const unsigned (&rq)[8], const unsigned (&rk)[8], const unsigned (&rv)[8], int p, int lane, float (&cumD)[2]) {
    const int cpl = lane & 15, tg = lane >> 4; const bool first = tg < 2, odd = (tg & 1) != 0;
    const int ch0 = 32 * p + 2 * cpl, cpos = (ch0 & ~15) + perm16(ch0 & 15), hpos = 16 * (tg >> 1) + (odd ? 4 : 0);
    float lf[2][8], lbw[2][8], fs[2], bs[2], qis[2], kts[2];
#pragma unroll
    for (int ci = 0; ci < 2; ++ci) {
        lf[ci][0] = 1.f - (ci ? bfhi(rk[0]) : bflo(rk[0]));
#pragma unroll
        for (int i = 1; i < 8; ++i) lf[ci][i] = lf[ci][i - 1] * (1.f - (ci ? bfhi(rk[i]) : bflo(rk[i])));
        lbw[ci][7] = 1.f;
#pragma unroll
        for (int i = 6; i >= 0; --i) lbw[ci][i] = lbw[ci][i + 1] * (1.f - (ci ? bfhi(rk[i + 1]) : bflo(rk[i + 1])));
        const float Tg = lf[ci][7];
        float Tn, HTo;
        { auto rr = __builtin_amdgcn_permlane16_swap(__float_as_uint(Tg), __float_as_uint(Tg), false, false); Tn = odd ? __uint_as_float(rr[0]) : __uint_as_float(rr[1]); }
        const float HT = Tg * Tn;
        { auto rr = __builtin_amdgcn_permlane32_swap(__float_as_uint(HT), __float_as_uint(HT), false, false); HTo = first ? __uint_as_float(rr[1]) : __uint_as_float(rr[0]); }
        fs[ci] = odd ? Tn : 1.f; bs[ci] = odd ? 1.f : Tn; qis[ci] = first ? 1.f : HTo; kts[ci] = first ? HTo : 1.f;
        cumD[ci] *= HT * HTo;
        if (tg == 0) *(LAS float*)(buf + HB_D + (ch0 + ci) * 4) = HT * HTo;
    }
    unsigned ktp[2][4];
#pragma unroll
    for (int i = 0; i < 8; i += 2) {
        float ktv[2][2];
#pragma unroll
        for (int e = 0; e < 2; ++e) {
            float qpv[2], kpv[2], qiv[2];
#pragma unroll
            for (int ci = 0; ci < 2; ++ci) { const float k = ci ? bfhi(rk[i + e]) : bflo(rk[i + e]); const float fwd = lf[ci][i + e] * fs[ci], bwd = lbw[ci][i + e] * bs[ci];
                ktv[ci][e] = k * bwd * kts[ci];
                if (PASS == 2) { const float q = ci ? bfhi(rq[i + e]) : bflo(rq[i + e]); const float X = first ? bwd : fwd; const float inv = __builtin_amdgcn_rcpf(fmaxf(X, 1e-30f));
                    qpv[ci] = q * (first ? inv : X); kpv[ci] = k * (first ? X : inv); qiv[ci] = q * fwd * qis[ci]; } }
            if (PASS == 2) { const int off = (8 * tg + i + e) * HG_QSTR + cpos * 2;
                *(LAS unsigned*)(buf + HB_QP + off) = cvtpk(qpv[0], qpv[1]); *(LAS unsigned*)(buf + HB_KP + off) = cvtpk(kpv[0], kpv[1]); *(LAS unsigned*)(buf + HB_QI + off) = cvtpk(qiv[0], qiv[1]); }
        }
        ktp[0][i >> 1] = cvtpk(ktv[0][0], ktv[0][1]); ktp[1][i >> 1] = cvtpk(ktv[1][0], ktv[1][1]);
    }
#pragma unroll
    for (int ci = 0; ci < 2; ++ci) {
        *(LAS v2u*)(buf + HB_KT + (ch0 + ci) * HG_TSTR + hpos * 2) = (v2u){ktp[ci][0], ktp[ci][1]}; *(LAS v2u*)(buf + HB_KT + (ch0 + ci) * HG_TSTR + hpos * 2 + 16) = (v2u){ktp[ci][2], ktp[ci][3]};
        v2u x0, x1;
        if (ci == 0) { x0.x = (rv[0] & 0xffffu) | (rv[1] << 16); x0.y = (rv[2] & 0xffffu) | (rv[3] << 16); x1.x = (rv[4] & 0xffffu) | (rv[5] << 16); x1.y = (rv[6] & 0xffffu) | (rv[7] << 16); }
        else { x0.x = (rv[0] >> 16) | (rv[1] & 0xffff0000u); x0.y = (rv[2] >> 16) | (rv[3] & 0xffff0000u); x1.x = (rv[4] >> 16) | (rv[5] & 0xffff0000u); x1.y = (rv[6] >> 16) | (rv[7] & 0xffff0000u); }
        *(LAS v2u*)(buf + HB_VT + (ch0 + ci) * HG_TSTR + hpos * 2) = x0; *(LAS v2u*)(buf + HB_VT + (ch0 + ci) * HG_TSTR + hpos * 2 + 16) = x1;
    }
}
__device__ __forceinline__ unsigned gld32(const void* p) { unsigned r; asm volatile("global_load_dword %0, %1, off" : "=v"(r) : "v"(p)); return r; }
__device__ __forceinline__ v4u gld128(const void* p) { v4u r; asm volatile("global_load_dwordx4 %0, %1, off" : "=v"(r) : "v"(p)); return r; }
#define HG_R8(a) "+v"(a[0]), "+v"(a[1]), "+v"(a[2]), "+v"(a[3]), "+v"(a[4]), "+v"(a[5]), "+v"(a[6]), "+v"(a[7])
template <int PASS>
__device__ __forceinline__ void hg_wait_set(unsigned (&rq)[8], unsigned (&rk)[8], unsigned (&rv)[8]) {
    if (PASS == 2) asm volatile("s_waitcnt vmcnt(24)" : HG_R8(rq), HG_R8(rk), HG_R8(rv));
    else asm volatile("s_waitcnt vmcnt(16)" : HG_R8(rk), HG_R8(rv));
}
template <int PASS>
__device__ __forceinline__ void hg_drain_set(unsigned (&rq)[8], unsigned (&rk)[8], unsigned (&rv)[8]) {
    if (PASS == 2) asm volatile("s_waitcnt vmcnt(0)" : HG_R8(rq), HG_R8(rk), HG_R8(rv));
    else asm volatile("s_waitcnt vmcnt(0)" : HG_R8(rk), HG_R8(rv));
}
template <int PASS>
__device__ __forceinline__ void hg_load(unsigned (&rq)[8], unsigned (&rk)[8], unsigned (&rv)[8], const bf16* prow  ) {
#pragma unroll
    for (int i = 0; i < 8; ++i) { const bf16* r = prow + (size_t)i * INC; if (PASS == 2) rq[i] = gld32(r + C_HQ); rk[i] = gld32(r + C_HF); rv[i] = gld32(r + C_HI); }
}
template <int PASS>
__device__ __forceinline__ void hg_consume(const LAS unsigned char* buf, f32x16 (&S)[4], f32x16& o, int w, int lane) {
    const int ql = lane & 31, hh = lane >> 5;
    const LAS unsigned char* qrow = buf + ql * HG_QSTR + 16 * hh;
    const LAS unsigned char* vrow = buf + HB_VT + (32 * w + ql) * HG_TSTR + 16 * hh;
    const bf16x8 vt0 = *(const LAS bf16x8*)(vrow), vt1 = *(const LAS bf16x8*)(vrow + 32);
    if (PASS == 2) {
        f32x16 at; const f32x16 zero16 = {0.f, 0.f, 0.f, 0.f, 0.f, 0.f, 0.f, 0.f, 0.f, 0.f, 0.f, 0.f, 0.f, 0.f, 0.f, 0.f};
#pragma unroll
        for (int kap = 0; kap < 8; ++kap) { const bf16x8 kf = *(const LAS bf16x8*)(qrow + HB_KP + 32 * kap), qf = *(const LAS bf16x8*)(qrow + HB_QP + 32 * kap);
            at = __builtin_amdgcn_mfma_f32_32x32x16_bf16(kf, qf, kap == 0 ? zero16 : at, 0, 0, 0); }
#pragma unroll
        for (int tile = 0; tile < 4; ++tile)
#pragma unroll
            for (int k2 = 0; k2 < 2; ++k2) { v4u sw; sw.x = cvtpk(S[tile][8 * k2], S[tile][8 * k2 + 1]); sw.y = cvtpk(S[tile][8 * k2 + 2], S[tile][8 * k2 + 3]);
                sw.z = cvtpk(S[tile][8 * k2 + 4], S[tile][8 * k2 + 5]); sw.w = cvtpk(S[tile][8 * k2 + 6], S[tile][8 * k2 + 7]);
                const bf16x8 qf = *(const LAS bf16x8*)(qrow + HB_QI + 32 * (2 * tile + k2));
                o = __builtin_amdgcn_mfma_f32_32x32x16_bf16(__builtin_bit_cast(bf16x8, sw), qf, (tile == 0 && k2 == 0) ? zero16 : o, 0, 0, 0); }
        const int lim = ql - 4 * hh;
#pragma unroll
        for (int i = 0; i < 16; ++i) at[i] = (((i & 3) + 8 * (i >> 2)) <= lim) ? at[i] : 0.f;
        v4u p0, p1; p0.x = cvtpk(at[0], at[1]); p0.y = cvtpk(at[2], at[3]); p0.z = cvtpk(at[4], at[5]); p0.w = cvtpk(at[6], at[7]);
        p1.x = cvtpk(at[8], at[9]); p1.y = cvtpk(at[10], at[11]); p1.z = cvtpk(at[12], at[13]); p1.w = cvtpk(at[14], at[15]);
        o = __builtin_amdgcn_mfma_f32_32x32x16_bf16(vt0, __builtin_bit_cast(bf16x8, p0), o, 0, 0, 0);
        o = __builtin_amdgcn_mfma_f32_32x32x16_bf16(vt1, __builtin_bit_cast(bf16x8, p1), o, 0, 0, 0);
    }
#pragma unroll
    for (int tile = 0; tile < 4; ++tile) {
#pragma unroll
        for (int g = 0; g < 4; ++g) { const f32x4 dv = *(const LAS f32x4*)(buf + HB_D + (32 * tile + 8 * g + 4 * hh) * 4);
            S[tile][4 * g] *= dv[0]; S[tile][4 * g + 1] *= dv[1]; S[tile][4 * g + 2] *= dv[2]; S[tile][4 * g + 3] *= dv[3]; }
        const LAS unsigned char* krow = buf + HB_KT + (32 * tile + ql) * HG_TSTR + 16 * hh;
        const bf16x8 k0 = *(const LAS bf16x8*)(krow), k1 = *(const LAS bf16x8*)(krow + 32);
        S[tile] = __builtin_amdgcn_mfma_f32_32x32x16_bf16(k0, vt0, S[tile], 0, 0, 0);
        S[tile] = __builtin_amdgcn_mfma_f32_32x32x16_bf16(k1, vt1, S[tile], 0, 0, 0);
    }
}
constexpr int HG_OSTR = 528, HG_OB = 2 * HB_SIZE, HG_OBSZ = 32 * HG_OSTR, HG_NW = HG_OB + 2 * HG_OBSZ;
__device__ __forceinline__ void hg_finish(const LAS unsigned char* ob, const v4u g0, const v4u g1  , const LAS float* nwl  , bf16* mrow  , int p, int lane) {
    const int tl = lane >> 3, vg = lane & 7;
    const LAS unsigned char* orow = ob + (8 * p + tl) * HG_OSTR + vg * 64;
    f32x4 ov[4]; float ss = 0.f;
#pragma unroll
    for (int j = 0; j < 4; ++j) { ov[j] = *(const LAS f32x4*)(orow + 16 * j); ss += (ov[j][0] * ov[j][0] + ov[j][1] * ov[j][1]) + (ov[j][2] * ov[j][2] + ov[j][3] * ov[j][3]); }
    ss += __shfl_xor(ss, 1); ss += __shfl_xor(ss, 2); ss += __shfl_xor(ss, 4);
    const float rstd = rsqrtf(ss * (1.f / 128.f) + EPS);
    unsigned r[8];
#pragma unroll
    for (int j = 0; j < 4; ++j) { const f32x4 wv = *(const LAS f32x4*)(nwl + 4 * j); const unsigned ga = (j < 2) ? g0[2 * j] : g1[2 * j - 4], gb = (j < 2) ? g0[2 * j + 1] : g1[2 * j - 3];
        r[2 * j] = cvtpk(ov[j][0] * rstd * wv[0] * bflo(ga), ov[j][1] * rstd * wv[1] * bfhi(ga)); r[2 * j + 1] = cvtpk(ov[j][2] * rstd * wv[2] * bflo(gb), ov[j][3] * rstd * wv[3] * bfhi(gb)); }
    if constexpr (OUTPROJ_FP8) {
        unsigned q[4]; const float rs = rstd * SC_MIX;
#pragma unroll
        for (int j = 0; j < 4; ++j) { const f32x4 wv = *(const LAS f32x4*)(nwl + 4 * j); const unsigned ga = (j < 2) ? g0[2 * j] : g1[2 * j - 4], gb = (j < 2) ? g0[2 * j + 1] : g1[2 * j - 3];
            q[j] = pk4_fp8(ov[j][0] * rs * wv[0] * bflo(ga), ov[j][1] * rs * wv[1] * bfhi(ga), ov[j][2] * rs * wv[2] * bflo(gb), ov[j][3] * rs * wv[3] * bfhi(gb)); }
        *(v4u*)((unsigned char*)mrow) = (v4u){q[0], q[1], q[2], q[3]}; return; }
    *(v4u*)(mrow) = (v4u){r[0], r[1], r[2], r[3]}; *(v4u*)(mrow + 8) = (v4u){r[4], r[5], r[6], r[7]};
}
template <int PASS>
__device__ __forceinline__ void phase_hgrn(const Ctx& F, const Args& A) {
    const bf16* PROJ = (const bf16*)(A.ws + WS_PROJ); bf16* MIX = (bf16*)(A.ws + WS_MIX); float* TSEG_ = (float*)(A.ws + WS_TSEG); float* DSEG = (float*)(A.ws + WS_DSEG); const float* nw_ = A.in[10];
    LAS unsigned char* buf0 = F.lds; LAS unsigned char* buf1 = F.lds + HB_SIZE; LAS unsigned char* ob0 = F.lds + HG_OB; LAS unsigned char* ob1 = ob0 + HG_OBSZ;
    const bool producer = F.wave >= 4; const int w = F.wave & 3, ql = F.lane & 31, hh = F.lane >> 5;
    for (int uid = F.vcu; uid < BATCH * 4 * HG_NSEG; uid += F.G) {
        const int seg = uid % HG_NSEG, h = (uid / HG_NSEG) & 3, b = uid / (HG_NSEG * 4);
        const size_t tok0 = (size_t)b * SEQ + (size_t)seg * HG_SEG;
        const GAS float* nw = (const GAS float*)nw_; GAS float* TSEG = (GAS float*)TSEG_; asm volatile("" : "+s"(nw), "+s"(TSEG));
        __syncthreads();
        if (PASS == 2) { LAS float* dl = (LAS float*)(F.lds + HG_OB); for (int i = F.tid; i < seg * 128; i += 512) dl[i] = DSEG[(size_t)(uid - seg) * 128 + i]; if (F.tid < 128) ((LAS float*)(F.lds + HG_NW))[F.tid] = nw[F.tid]; }
        __syncthreads();
        if (producer) {
            unsigned rq0[8], rk0[8], rv0[8], rq1[8], rk1[8], rv1[8]; float cumD[2] = {1.f, 1.f};
#pragma unroll
            for (int i = 0; i < 8; ++i) { rq0[i] = 0u; rq1[i] = 0u; }
            const bf16* pbase = PROJ + (tok0 + 8 * (F.lane >> 4)) * INC + h * 128 + 32 * w + 2 * (F.lane & 15);
            hg_load<PASS>(rq0, rk0, rv0, pbase); hg_load<PASS>(rq1, rk1, rv1, pbase + (size_t)32 * INC);
            const size_t ftok = tok0 + 8 * w + (F.lane >> 3); const int fcol = h * 128 + 16 * (F.lane & 7);
            const LAS float* nwv = (const LAS float*)(F.lds + HG_NW) + 16 * (F.lane & 7);
            const bf16* gbase = PROJ + ftok * INC + C_HG + fcol;
            v4u ga0 = {0u, 0u, 0u, 0u}, ga1 = ga0, gb0 = ga0, gb1 = ga0;
            if (PASS == 2) { ga0 = gld128(gbase); ga1 = gld128(gbase + 8); }
            LDS_BARRIER();
#define HG_CL(c) ((c) < 0 ? 0 : ((c) > HG_NCH - 1 ? HG_NCH - 1 : (c)))
#pragma unroll 1
            for (int sp = -1; sp < HG_NCH; sp += 2) {
                if (PASS == 2) { const bf16* gp = gbase + (size_t)(32 * HG_CL(sp)) * INC; gb0 = gld128(gp); gb1 = gld128(gp + 8); }
                hg_wait_set<PASS>(rq0, rk0, rv0);
                if (sp + 1 < HG_NCH) hg_produce<PASS>(buf0, rq0, rk0, rv0, w, F.lane, cumD);
                hg_load<PASS>(rq0, rk0, rv0, pbase + (size_t)(32 * HG_CL(sp + 3)) * INC);
                if (PASS == 2) { asm volatile("s_waitcnt vmcnt(24)" : "+v"(ga0), "+v"(ga1));
                    if (sp >= 1) hg_finish(ob0, ga0, ga1, nwv, OUTPROJ_FP8 ? (bf16*)((unsigned char*)MIX + (ftok + 32 * (sp - 1)) * DM + 512 + fcol) : MIX + (ftok + 32 * (sp - 1)) * DM + 512 + fcol, w, F.lane); }
                LDS_BARRIER();
                if (PASS == 2) { const bf16* gp = gbase + (size_t)(32 * HG_CL(sp + 1)) * INC; ga0 = gld128(gp); ga1 = gld128(gp + 8); }
                hg_wait_set<PASS>(rq1, rk1, rv1);
                if (sp + 2 < HG_NCH) hg_produce<PASS>(buf1, rq1, rk1, rv1, w, F.lane, cumD);
                hg_load<PASS>(rq1, rk1, rv1, pbase + (size_t)(32 * HG_CL(sp + 4)) * INC);
                if (PASS == 2) { asm volatile("s_waitcnt vmcnt(24)" : "+v"(gb0), "+v"(gb1));
                    if (sp >= 0) hg_finish(ob1, gb0, gb1, nwv, OUTPROJ_FP8 ? (bf16*)((unsigned char*)MIX + (ftok + 32 * sp) * DM + 512 + fcol) : MIX + (ftok + 32 * sp) * DM + 512 + fcol, w, F.lane); }
                LDS_BARRIER();
            }
#undef HG_CL
            hg_drain_set<PASS>(rq0, rk0, rv0); hg_drain_set<PASS>(rq1, rk1, rv1);
            if (PASS == 2) asm volatile("" : "+v"(ga0), "+v"(ga1), "+v"(gb0), "+v"(gb1));
            if (PASS == 1 && (F.lane >> 4) == 0) { DSEG[(size_t)uid * 128 + 32 * w + 2 * (F.lane & 15)] = cumD[0]; DSEG[(size_t)uid * 128 + 32 * w + 2 * (F.lane & 15) + 1] = cumD[1]; }
        } else {
            f32x16 S[4];
#pragma unroll
            for (int t = 0; t < 4; ++t)
#pragma unroll
                for (int i = 0; i < 16; ++i) S[t][i] = 0.f;
            if (PASS == 2 && seg > 0) {
                const LAS float* dl = (const LAS float*)(F.lds + HG_OB);
                const GAS float* Tl = TSEG + (size_t)(uid - seg) * 16384 + (size_t)(w * 64 + F.lane) * 64;
#pragma unroll
                for (int hf = 0; hf < 2; ++hf) {
                    f32x4 Tn[8];
#pragma unroll
                    for (int x = 0; x < 8; ++x) Tn[x] = *(const GAS f32x4*)(Tl + 32 * hf + 4 * x);
                    for (int j = 0; j < seg; ++j) {
                        f32x4 Tc[8];
#pragma unroll
                        for (int x = 0; x < 8; ++x) Tc[x] = Tn[x];
                        if (j + 1 < seg) {
#pragma unroll
                            for (int x = 0; x < 8; ++x) Tn[x] = *(const GAS f32x4*)(Tl + (size_t)(j + 1) * 16384 + 32 * hf + 4 * x); }
#pragma unroll
                        for (int tt = 0; tt < 2; ++tt)
#pragma unroll
                            for (int g = 0; g < 4; ++g) { const int t = 2 * hf + tt; const f32x4 dv = *(const LAS f32x4*)(dl + j * 128 + 32 * t + 8 * g + 4 * hh);
#pragma unroll
                                for (int e = 0; e < 4; ++e) S[t][4 * g + e] = dv[e] * S[t][4 * g + e] + Tc[4 * tt + g][e]; }
                    }
                }
            }
            LDS_BARRIER();
            const int ooff = ql * HG_OSTR + (32 * w + 4 * hh) * 4;
#pragma unroll 1
            for (int sp = -1; sp < HG_NCH; sp += 2) {
                if (sp >= 0) { f32x16 o; hg_consume<PASS>(buf1, S, o, w, F.lane);
                    if (PASS == 2) {
#pragma unroll
                        for (int g = 0; g < 4; ++g) *(LAS f32x4*)(ob1 + ooff + 32 * g) = (f32x4){o[4 * g], o[4 * g + 1], o[4 * g + 2], o[4 * g + 3]}; } }
                LDS_BARRIER();
                if (sp + 1 < HG_NCH) { f32x16 o; hg_consume<PASS>(buf0, S, o, w, F.lane);
                    if (PASS == 2) {
#pragma unroll
                        for (int g = 0; g < 4; ++g) *(LAS f32x4*)(ob0 + ooff + 32 * g) = (f32x4){o[4 * g], o[4 * g + 1], o[4 * g + 2], o[4 * g + 3]}; } }
                LDS_BARRIER();
            }
            if (PASS == 1) { GAS float* Tl = TSEG + (size_t)uid * 16384 + (size_t)(w * 64 + F.lane) * 64;
#pragma unroll
                for (int t = 0; t < 4; ++t)
#pragma unroll
                    for (int g = 0; g < 4; ++g) *(GAS f32x4*)(Tl + 16 * t + 4 * g) = (f32x4){S[t][4 * g], S[t][4 * g + 1], S[t][4 * g + 2], S[t][4 * g + 3]}; }
        }
    }
    __syncthreads();
}

__device__ __forceinline__ void route_preload(const Ctx& F, const Args& A) {
    const float* mod = (const float*)(A.ws + WS_MOD); const float* gf = A.in[13]; const v4u* wrf = (const v4u*)(A.ws + WS_WRF);
    LAS v4u* wl = (LAS v4u*)F.lds; LAS float* G2 = (LAS float*)(F.lds + 131072); LAS float* SH = G2 + 1024;
    if (F.vcu >= NTOK / 128) return;
    const int b = (F.vcu * 128) >> 12;
    __syncthreads();
#pragma unroll 1
    for (int hb = 0; hb < 2; ++hb) { v4u t8[8];
#pragma unroll
        for (int i = 0; i < 8; ++i) t8[i] = wrf[F.tid + 512 * (8 * hb + i)];
#pragma unroll
        for (int i = 0; i < 8; ++i) wl[F.tid + 512 * (8 * hb + i)] = t8[i]; }
    for (int k = F.tid; k < 1024; k += 512) { G2[k] = gf[k] * (1.f + mod[b * 6144 + 4096 + k]); SH[k] = mod[b * 6144 + 3072 + k]; }
    __syncthreads();
}
template <bool PRE>
__device__ __forceinline__ void phase_route(const Ctx& F, const Args& A) {
    const bf16* XM = (const bf16*)(A.ws + WS_XM); const float* mod = (const float*)(A.ws + WS_MOD); const float* gf = A.in[13]; const float* SSQ = (const float*)(A.ws + WS_SSQP); const float* SHW = (const float*)(A.ws + WS_SHW);
    bf16* H = (bf16*)(A.ws + WS_H); const v4u* wrf = (const v4u*)(A.ws + WS_WRF);
    int* TKE = (int*)(A.ws + WS_TKE); float* TKW = (float*)(A.ws + WS_TKW); int* LIST = (int*)(A.ws + WS_LIST); int* RNK = (int*)(A.ws + WS_RNK); unsigned* cnt = (unsigned*)(A.ws + WS_CTL) + CW_CNT;
    LAS int* hist = (LAS int*)(F.lds + L_HIST); LAS int* base = (LAS int*)(F.lds + L_BASE);
    LAS v4u* wl = (LAS v4u*)F.lds; LAS float* G2 = (LAS float*)(F.lds + 131072); LAS float* SH = G2 + 1024;
    const int tr = F.lane & 15, q = F.lane >> 4;
    int cur_b = PRE ? (F.vcu * 128) >> 12 : -1;
    for (int item = F.vcu; item < NTOK / 128; item += F.G) {
        const int tok0 = item * 128 + F.wave * 16, b = tok0 >> 12;
        __syncthreads();
        if (cur_b < 0) {
#pragma unroll 1
            for (int hb = 0; hb < 2; ++hb) { v4u t8[8];
#pragma unroll
                for (int i = 0; i < 8; ++i) t8[i] = wrf[F.tid + 512 * (8 * hb + i)];
#pragma unroll
                for (int i = 0; i < 8; ++i) wl[F.tid + 512 * (8 * hb + i)] = t8[i]; } }
        if (b != cur_b) { for (int k = F.tid; k < 1024; k += 512) { G2[k] = gf[k] * (1.f + mod[b * 6144 + 4096 + k]); SH[k] = mod[b * 6144 + 3072 + k]; } cur_b = b; }
        if (F.tid < 32) hist[F.tid] = 0;
        __syncthreads();
#define RT_CS(s) (MOE1_FP6 ? 128 * ((s) >> 2) + 8 * ((s) & 3) : 32 * (s))
        const int kq = MOE1_FP6 ? 32 * q : 8 * q;
        const bf16* xrow = XM + (size_t)(tok0 + tr) * DM + kq;
        constexpr int RT_PF = 8;
        v4u xa[RT_PF];
#pragma unroll
        for (int s = 0; s < RT_PF; ++s) xa[s] = *(const v4u*)(xrow + RT_CS(s));
        f32x16_ h6lo, h6hi;
        float rstd;
        { const f32x4 p4 = *(const f32x4*)(SSQ + (size_t)(tok0 + tr) * 16 + 4 * q); float ss = (p4[0] + p4[1]) + (p4[2] + p4[3]); ss += __shfl_xor(ss, 16); ss += __shfl_xor(ss, 32); rstd = rsqrtf(ss * (1.f / DM) + EPS); }
        f32x4 acc0 = {0.f, 0.f, 0.f, 0.f}, acc1 = {0.f, 0.f, 0.f, 0.f};
        unsigned char* hrow = (unsigned char*)H + (size_t)(tok0 + tr) * DM + (MOE1_FP6 ? 16 * q : 8 * q);
#pragma unroll 1
        for (int so = 0; so < 4; ++so)
#pragma unroll
        for (int si = 0; si < 8; ++si) { const int s = 8 * so + si, cs = 256 * so + RT_CS(si), k0 = cs + kq;
            float hv[8];
#pragma unroll
            for (int p = 0; p < 2; ++p) { const unsigned xw0 = p ? xa[si].z : xa[si].x, xw1 = p ? xa[si].w : xa[si].y; const f32x4 xv = {bflo(xw0), bfhi(xw0), bflo(xw1), bfhi(xw1)}, gv = *(const LAS f32x4*)(G2 + k0 + 4 * p), sh = *(const LAS f32x4*)(SH + k0 + 4 * p);
                const f32x4 h = xv * rstd * gv + sh; hv[4 * p] = h[0]; hv[4 * p + 1] = h[1]; hv[4 * p + 2] = h[2]; hv[4 * p + 3] = h[3]; }
            if constexpr (MOE1_FP6) {
                if ((si & 3) == 3 && so < 3) {
#pragma unroll
                    for (int t = 0; t < 4; ++t) xa[si - 3 + t] = *(const v4u*)(xrow + 256 * so + RT_CS(si - 3 + t) + 256); } }
            else if (so < 3) xa[si] = *(const v4u*)(xrow + cs + 256);
            v4u ph, pl; ph.x = cvtpk(hv[0], hv[1]); ph.y = cvtpk(hv[2], hv[3]); ph.z = cvtpk(hv[4], hv[5]); ph.w = cvtpk(hv[6], hv[7]);
            pl.x = cvtpk(hv[0] - bflo(ph.x), hv[1] - bfhi(ph.x)); pl.y = cvtpk(hv[2] - bflo(ph.y), hv[3] - bfhi(ph.y));
            pl.z = cvtpk(hv[4] - bflo(ph.z), hv[5] - bfhi(ph.z)); pl.w = cvtpk(hv[6] - bflo(ph.w), hv[7] - bfhi(ph.w));
            if constexpr (MOE1_FP6) {
#pragma unroll
                for (int j = 0; j < 8; ++j) { if ((si & 3) < 2) h6lo[8 * (si & 3) + j] = hv[j] * SC_H6; else h6hi[8 * ((si & 3) - 2) + j] = hv[j] * SC_H6; }
                if ((si & 3) == 3) { const v6u o = pk32_fp6(h6lo, h6hi); unsigned char* d = hrow + 256 * so + 128 * (si >> 2);
                    *(v4u*)d = (v4u){o[0], o[1], o[2], o[3]}; *(v2u*)(d + 64) = (v2u){o[4], o[5]}; } }
            else { v2u h8; h8.x = pk4_fp8(hv[0] * SC_H, hv[1] * SC_H, hv[2] * SC_H, hv[3] * SC_H); h8.y = pk4_fp8(hv[4] * SC_H, hv[5] * SC_H, hv[6] * SC_H, hv[7] * SC_H); *(v2u*)(hrow + 256 * so + 32 * si) = h8; }
            const bf16x8 ah = __builtin_bit_cast(bf16x8, ph), al = __builtin_bit_cast(bf16x8, pl);
            const bf16x8 bh0 = __builtin_bit_cast(bf16x8, wl[((s * 2 + 0) * 2 + 0) * 64 + F.lane]), bl0 = __builtin_bit_cast(bf16x8, wl[((s * 2 + 0) * 2 + 1) * 64 + F.lane]);
            const bf16x8 bh1 = __builtin_bit_cast(bf16x8, wl[((s * 2 + 1) * 2 + 0) * 64 + F.lane]), bl1 = __builtin_bit_cast(bf16x8, wl[((s * 2 + 1) * 2 + 1) * 64 + F.lane]);
            acc0 = __builtin_amdgcn_mfma_f32_16x16x32_bf16(ah, bh0, acc0, 0, 0, 0); acc0 = __builtin_amdgcn_mfma_f32_16x16x32_bf16(ah, bl0, acc0, 0, 0, 0); acc0 = __builtin_amdgcn_mfma_f32_16x16x32_bf16(al, bh0, acc0, 0, 0, 0);
            acc1 = __builtin_amdgcn_mfma_f32_16x16x32_bf16(ah, bh1, acc1, 0, 0, 0); acc1 = __builtin_amdgcn_mfma_f32_16x16x32_bf16(ah, bl1, acc1, 0, 0, 0); acc1 = __builtin_amdgcn_mfma_f32_16x16x32_bf16(al, bh1, acc1, 0, 0, 0);
        }
        const float br0 = A.in[15][tr], br1 = A.in[15][16 + tr];
        float tv[4][4]; int ti[4][4];
#pragma unroll
        for (int j = 0; j < 4; ++j) { float a = acc0[j] + br0, c = acc1[j] + br1;
#pragma unroll
            for (int r = 0; r < 4; ++r) { float bv = a >= c ? a : c; int bi = a >= c ? tr : tr + 16;
#pragma unroll
                for (int off = 1; off < 16; off <<= 1) { const float ov = __shfl_xor(bv, off); const int oi = __shfl_xor(bi, off); const bool take = (ov > bv) || (ov == bv && oi < bi); bv = take ? ov : bv; bi = take ? oi : bi; }
                tv[j][r] = bv; ti[j][r] = bi; if (bi == tr) a = -INFINITY; if (bi == tr + 16) c = -INFINITY; } }
        const int jj = (F.lane >> 2) & 3, kk = F.lane & 3;
        int e = 0; float w = 0.f;
#pragma unroll
        for (int j = 0; j < 4; ++j) { const float e1 = __expf(tv[j][1] - tv[j][0]), e2 = __expf(tv[j][2] - tv[j][0]), e3 = __expf(tv[j][3] - tv[j][0]); const float inv = 1.f / (1.f + e1 + e2 + e3);
            const float wk[4] = {inv, e1 * inv, e2 * inv, e3 * inv};
#pragma unroll
            for (int r = 0; r < 4; ++r) if (jj == j && kk == r) { e = ti[j][r]; w = wk[r]; } }
        const int slot = (tok0 + 4 * q + jj) * 4 + kk;
        TKE[slot] = e; TKW[slot] = w;
        const int rank = __hip_atomic_fetch_add(hist + e, 1, __ATOMIC_RELAXED, __HIP_MEMORY_SCOPE_WORKGROUP);
        __syncthreads();
        if (F.tid < 32) base[F.tid] = (int)__hip_atomic_fetch_add(cnt + 16 * F.tid, (unsigned)hist[F.tid], RLX_AGENT);
        __syncthreads();
        LIST[e * LIST_CAP + base[e] + rank] = slot; RNK[slot] = base[e] + rank;
    }
    __syncthreads();
}

__device__ __forceinline__ void phase_final(const Ctx& F, const Args& A) {
    const bf16* XM = (const bf16*)(A.ws + WS_XM); const float* mod = (const float*)(A.ws + WS_MOD); const unsigned char* Y = A.ws + WS_Y;
    const float* TKW = (const float*)(A.ws + WS_TKW); const float* gfin = A.in[20]; float* out = A.out;
    const int* TKE = (const int*)(A.ws + WS_TKE); const int* RNK = (const int*)(A.ws + WS_RNK); const LAS int* tb = (const LAS int*)(F.lds + L_TB);
    const int gw = F.vcu * 8 + F.wave, NGW = F.G * 8, c0 = 16 * F.lane;
    LAS unsigned char* img = F.lds + F.wave * 10240;
    const int own = F.lane * 80, coal = (F.lane >> 2) * 80 + (F.lane & 3) * 16;
    const int coal2 = (F.lane >> 1) * 80 + (F.lane & 1) * 16;
    for (int m0 = 2 * gw; m0 < NTOK; m0 += 2 * NGW) {
        const int b = m0 >> 12;
        v4u y[2][4]; f32x4 xv[2][4]; f32x4 wk[2]; v4u xb[2][2];
#pragma unroll
        for (int r = 0; r < 2; ++r) { const size_t m = (size_t)(m0 + r); wk[r] = *(const f32x4*)(TKW + m * 4);
#pragma unroll
            for (int k = 0; k < 4; ++k) { const int e = TKE[m * 4 + k], rk = RNK[m * 4 + k]; y[r][k] = *(const v4u*)(Y + (size_t)(tb[e] * 256 + rk) * DM + c0); }
#pragma unroll
            for (int j = 0; j < 2; ++j) xb[r][j] = *(const v4u*)(XM + m * DM + 8 * (F.lane + 64 * j)); }
        f32x4 gt[4], gf[4];
#pragma unroll
        for (int j = 0; j < 4; ++j) { gt[j] = *(const f32x4*)(mod + b * 6144 + 5120 + c0 + 4 * j) * (1.f / SC_Y); gf[j] = *(const f32x4*)(gfin + c0 + 4 * j); }
#pragma unroll
        for (int r = 0; r < 2; ++r)
#pragma unroll
            for (int j = 0; j < 2; ++j) *(LAS v4u*)(img + r * 5120 + coal2 + 2560 * j) = xb[r][j];
        asm volatile("s_waitcnt lgkmcnt(0)" ::: "memory");
#pragma unroll
        for (int r = 0; r < 2; ++r)
#pragma unroll
            for (int j = 0; j < 2; ++j) { const v4u t = *(const LAS v4u*)(img + r * 5120 + own + 16 * j);
                xv[r][2 * j] = (f32x4){bflo(t.x), bfhi(t.x), bflo(t.y), bfhi(t.y)}; xv[r][2 * j + 1] = (f32x4){bflo(t.z), bfhi(t.z), bflo(t.w), bfhi(t.w)}; }
        float ss[2] = {0.f, 0.f};
#pragma unroll
        for (int r = 0; r < 2; ++r)
#pragma unroll
            for (int j = 0; j < 4; ++j) { f32x4 moe = {0.f, 0.f, 0.f, 0.f};
#pragma unroll
                for (int k = 0; k < 4; ++k) { const int w = (int)y[r][k][j]; const f32x2 lo = __builtin_amdgcn_cvt_pk_f32_fp8(w, false), hi = __builtin_amdgcn_cvt_pk_f32_fp8(w, true);
                    moe += (f32x4){lo.x, lo.y, hi.x, hi.y} * wk[r][k]; }
                xv[r][j] = xv[r][j] + gt[j] * moe; ss[r] += (xv[r][j][0] * xv[r][j][0] + xv[r][j][1] * xv[r][j][1]) + (xv[r][j][2] * xv[r][j][2] + xv[r][j][3] * xv[r][j][3]); }
        const float rs0 = rsqrtf(wave_sum(ss[0]) * (1.f / DM) + EPS), rs1 = rsqrtf(wave_sum(ss[1]) * (1.f / DM) + EPS);
        asm volatile("s_waitcnt lgkmcnt(0)" ::: "memory");
#pragma unroll
        for (int r = 0; r < 2; ++r)
#pragma unroll
            for (int j = 0; j < 4; ++j) *(LAS f32x4*)(img + r * 5120 + own + 16 * j) = xv[r][j] * (r ? rs1 : rs0) * gf[j];
        asm volatile("s_waitcnt lgkmcnt(0)" ::: "memory");
#pragma unroll
        for (int r = 0; r < 2; ++r)
#pragma unroll
            for (int j = 0; j < 4; ++j) *(f32x4*)(out + (size_t)(m0 + r) * DM + 4 * (F.lane + 64 * j)) = *(const LAS f32x4*)(img + r * 5120 + coal + 1280 * j);
        asm volatile("s_waitcnt lgkmcnt(0)" ::: "memory");
    }
}

constexpr int N_PHASES = 10;
__global__ void __launch_bounds__(512, 2) hymba_fwd(Args args) {
    extern __shared__ __attribute__((aligned(16))) unsigned char lds_raw[];
    Ctx F; F.lds = (LAS unsigned char*)lds_raw; F.tid = threadIdx.x; F.lane = F.tid & 63; F.wave = __builtin_amdgcn_readfirstlane(F.tid >> 6);
    F.G = gridDim.x; { const int bx = blockIdx.x; F.vcu = (F.G % 8 == 0) ? (bx % 8) * (F.G / 8) + bx / 8 : bx; }
    unsigned char* ws = args.ws; unsigned* ctl = (unsigned*)(ws + WS_CTL);
    for (int u = F.tid; u < 1024; u += 512) ((LAS unsigned*)(F.lds + LDSCTL_OFF))[u] = 0u;
    __syncthreads();
    XcdBarrier bar; bar.bar = ctl + CW_BAR; bar.x = 0; bar.st = nullptr;
    if (!MK_PER_PHASE) bar = xcd_barrier_post(ctl + CW_BAR, (volatile LAS unsigned*)(F.lds + L_BARW));
    const int lo = args.ph_lo, hi = args.ph_hi;
#define IN(k) (lo <= (k) && (k) < hi)
#define SEAM(k) do { if (IN(k) && IN((k) + 1)) xcd_barrier(bar); } while (0)

    if (IN(0)) { phase_prologue(F, args); } SEAM(0);
    if (IN(1)) { phase_norm1(F, args); } SEAM(1);
    if (IN(2)) {
        pg8::Gemm g{(const bf16*)(ws + WS_H), (const bf16*)(ws + WS_WIN), NTOK, INC, DM / 2, 0, nullptr}; pg8::StaticOrder S; S.init(NTOK, INC, F.G, (int)blockIdx.x);
        pg8::EpiProj E{(bf16*)(ws + WS_PROJ), args.in[6], args.in[9], 1.f / (SC_H * SC_W)};
        pg8::gemm_phase<pg8::EpiProj, pg8::StaticOrder, true, false, true>(F.lds, g, S, E);
        phase_wd_tail(F, args);
    } SEAM(2);
    if (IN(3)) { phase_attn(F, args); phase_hgrn<1>(F, args); } SEAM(3);
    if (IN(4)) { phase_hgrn<2>(F, args); } SEAM(4);
    if (IN(5)) {
        pg8::Gemm g{(const bf16*)(ws + WS_MIX), (const bf16*)(ws + WS_WOUT), NTOK, DM, OUTPROJ_FP8 ? DM / 2 : DM, 0, nullptr}; pg8::StaticOrder S; S.init(NTOK, DM, F.G, (int)blockIdx.x);
        pg8::EpiRes E{(bf16*)(ws + WS_XM), args.in[0], args.in[12], (const float*)(ws + WS_MOD), (float*)(ws + WS_SSQP), OUTPROJ_FP8 ? 1.f / (SC_MIX * SC_WO) : 1.f};
        pg8::gemm_phase<pg8::EpiRes, pg8::StaticOrder, true, false, OUTPROJ_FP8>(F.lds, g, S, E);
        if (IN(6)) route_preload(F, args);
    } SEAM(5);
    if (IN(6)) { if (IN(5)) phase_route<true>(F, args); else phase_route<false>(F, args); } SEAM(6);
    if (IN(7) || IN(8) || IN(9)) {
        LAS int* tb = (LAS int*)(F.lds + L_TB); LAS int* cn = (LAS int*)(F.lds + L_CN);
        if (F.tid < NEXP) cn[F.tid] = (int)__hip_atomic_load(ctl + CW_CNT + 16 * F.tid, RLX_AGENT);
        __syncthreads();
        if (F.tid == 0) { int t = 0; for (int e = 0; e < NEXP; ++e) { tb[e] = t; t += (cn[e] + 255) >> 8; } tb[NEXP] = t; }
        __syncthreads();
        { LAS int* te = (LAS int*)(F.lds + L_TE); for (int T = F.tid; T < tb[NEXP]; T += 512) { int e = 0; while (e < NEXP - 1 && tb[e + 1] <= T) ++e; te[T] = e; } }
        __syncthreads();
    }
    if (IN(7)) {
        const LAS int* tb = (const LAS int*)(F.lds + L_TB); const LAS int* cn = (const LAS int*)(F.lds + L_CN);
        pg8::Gemm g{(const bf16*)(ws + WS_H), (const bf16*)(ws + WS_WGU), NTOK, 2048, DM / 2, (size_t)2048 * DM / 2, (const int*)(ws + WS_LIST)};
        pg8::MoeOrder S{tb, cn, (const LAS int*)(F.lds + L_TE), 8, F.G, F.vcu, tb[NEXP]};
        pg8::EpiSwiglu E{ws + WS_ACT, args.in[17], MOE1_FP6 ? 1.f / (SC_H6 * SC_W6) : 1.f / (SC_H * SC_W)};
        pg8::gemm_phase<pg8::EpiSwiglu, pg8::MoeOrder, true, true, true, MOE1_FP6>(F.lds, g, S, E);
        phase_wd_tail2(F, args, S);
    } SEAM(7);
    if (IN(8)) {
        const LAS int* tb = (const LAS int*)(F.lds + L_TB); const LAS int* cn = (const LAS int*)(F.lds + L_CN);
        pg8::Gemm g{(const bf16*)(ws + WS_ACT), (const bf16*)(ws + WS_WD), MAX_MT * 256, DM, DFF / 2, (size_t)DM * DFF / 2, nullptr};
        pg8::MoeOrder S{tb, cn, (const LAS int*)(F.lds + L_TE), 4, F.G, F.vcu, tb[NEXP], true};
        pg8::EpiScatter E{ws + WS_Y, SC_Y / (SC_ACT * SC_W), args.in[19]};
        pg8::gemm_phase<pg8::EpiScatter, pg8::MoeOrder, true, false, true>(F.lds, g, S, E);
    } SEAM(8);
    if (IN(9)) { phase_final(F, args); }
#undef IN
#undef SEAM
}

extern "C" void kernel_launch(void* const* d_in, const int* in_sizes, int n_in, void* d_out, int out_size, void* d_ws, size_t ws_size, hipStream_t stream) {
    static int grid = 0;
    if (grid == 0) {
        if (n_in != 21 || in_sizes[0] != NTOK * DM || out_size != NTOK * DM || ws_size < WS_END) { fprintf(stderr, "kernel_launch: unexpected shapes / workspace (n_in %d, in0 %d, out %d, ws %zu, need %zu)\n", n_in, n_in > 0 ? in_sizes[0] : -1, out_size, ws_size, (size_t)WS_END); grid = -1; return; }
        int dev = 0, cus = 0, per_cu = 0;
        if (hipGetDevice(&dev) != hipSuccess || hipDeviceGetAttribute(&cus, hipDeviceAttributeMultiprocessorCount, dev) != hipSuccess) { grid = -1; return; }
        if (hipFuncSetAttribute((const void*)hymba_fwd, hipFuncAttributeMaxDynamicSharedMemorySize, LDS_BYTES) != hipSuccess) { fprintf(stderr, "kernel_launch: hipFuncSetAttribute failed\n"); grid = -1; return; }
        if (hipOccupancyMaxActiveBlocksPerMultiprocessor(&per_cu, (const void*)hymba_fwd, 512, LDS_BYTES) != hipSuccess || per_cu < 1) fprintf(stderr, "kernel_launch: occupancy query reports %d\n", per_cu);
        (void)hipGetLastError();
        grid = cus;
    }
    if (grid < 0) return;
    if (hipMemsetAsync((char*)d_ws + WS_CTL, 0, CTL_ZERO_BYTES, stream) != hipSuccess) return;
    Args a{};
    for (int i = 0; i < 21; ++i) a.in[i] = (const float*)d_in[i];
    a.out = (float*)d_out; a.ws = (unsigned char*)d_ws;
#if MK_PER_PHASE
    for (int ph = 0; ph < N_PHASES; ++ph) { a.ph_lo = ph; a.ph_hi = ph + 1; hipLaunchKernelGGL(hymba_fwd, dim3(grid), dim3(512), LDS_BYTES, stream, a); }
#else
    a.ph_lo = 0; a.ph_hi = N_PHASES; hipLaunchKernelGGL(hymba_fwd, dim3(grid), dim3(512), LDS_BYTES, stream, a);
#endif
}
```

```cpp
#include <hip/hip_runtime.h>
#include <cstdio>
#include <cstdint>

#ifndef MK_PER_PHASE
#define MK_PER_PHASE 0
#endif

#define GAS __attribute__((address_space(1)))
#define LAS __attribute__((address_space(3)))
typedef unsigned short bf16;
typedef unsigned v4u __attribute__((ext_vector_type(4)));
typedef unsigned v2u __attribute__((ext_vector_type(2)));
typedef float f32x4 __attribute__((ext_vector_type(4)));
typedef float f32x2 __attribute__((ext_vector_type(2)));
typedef short bf16x8 __attribute__((ext_vector_type(8)));
#define RLX_AGENT __ATOMIC_RELAXED, __HIP_MEMORY_SCOPE_AGENT
#define LDS_WAIT() asm volatile("s_waitcnt lgkmcnt(0)" ::: "memory")
#define VM_WAIT() asm volatile("s_waitcnt vmcnt(0)" ::: "memory")
#define LDS_BARRIER() asm volatile("s_waitcnt lgkmcnt(0)\n\ts_barrier" ::: "memory")

constexpr int BATCH = 8, SEQ = 4096, DM = 1024, NTOK = BATCH * SEQ;
constexpr int INC = 2816;
constexpr int C_AQ = 0, C_AK = 512, C_AV = 640, C_HQ = 768, C_HF = 1280, C_HI = 1792, C_HG = 2304;
constexpr int NEXP = 32, TOPK = 4, DFF = 1024;
constexpr float EPS = 1e-5f;
constexpr int LIST_CAP = NTOK;
constexpr int MAX_MT = (NTOK * TOPK) / 256 + NEXP;

constexpr size_t MiB = 1u << 20;
constexpr size_t WS_CTL = 0, CTL_ZERO_BYTES = 64 * 1024;
constexpr size_t WS_MOD = 1 * MiB;
constexpr size_t WS_WRF = 1 * MiB + 512 * 1024;
constexpr size_t WS_SHW = 1 * MiB + 256 * 1024;
constexpr size_t WS_SSQP = 928 * MiB;
constexpr size_t WS_TKE = 2 * MiB, WS_TKW = 2 * MiB + 512 * 1024;
constexpr size_t WS_RNK = 3 * MiB;
constexpr size_t WS_LIST = 4 * MiB;
constexpr size_t WS_WIN = 8 * MiB, WS_WOUT = 14 * MiB;
constexpr size_t WS_WGU = 16 * MiB, WS_WD = 144 * MiB;
constexpr size_t WS_H = 208 * MiB;
constexpr size_t WS_XM = 272 * MiB;
constexpr size_t WS_PROJ = 400 * MiB, WS_MIX = 576 * MiB;
constexpr size_t WS_Y = 400 * MiB;
constexpr size_t WS_ACT = 656 * MiB;
constexpr size_t WS_TSEG = 656 * MiB, WS_DSEG = 672 * MiB;
constexpr size_t WS_END = 930 * MiB;
static_assert(WS_ACT + (size_t)MAX_MT * 256 * 1024 * 2 <= WS_END, "ws map");
constexpr int CW_TMO = 0, CW_CODE = 1, CW_BAR = 4096, CW_CNT = 8192;

constexpr int LDS_BYTES = 147456;
constexpr int LDSCTL_OFF = LDS_BYTES - 4096;
constexpr int L_BARW = LDSCTL_OFF;
constexpr int L_TB = LDSCTL_OFF + 64;
constexpr int L_CN = LDSCTL_OFF + 256;
constexpr int L_HIST = LDSCTL_OFF + 512;
constexpr int L_BASE = LDSCTL_OFF + 640;
constexpr int L_TE = LDSCTL_OFF + 1024;

__device__ __forceinline__ unsigned f2bf(float f) { unsigned u = __builtin_bit_cast(unsigned, f); return (u + 0x7fffu + ((u >> 16) & 1u)) >> 16; }
__device__ __forceinline__ unsigned pk2(float lo, float hi) { return f2bf(lo) | (f2bf(hi) << 16); }
__device__ __forceinline__ float bf2f(unsigned b) { return __builtin_bit_cast(float, b << 16); }
typedef __bf16 bf16x2_t __attribute__((ext_vector_type(2)));
__device__ __forceinline__ unsigned cvtpk(float lo, float hi) { f32x2 v = {lo, hi}; bf16x2_t b = __builtin_convertvector(v, bf16x2_t); return __builtin_bit_cast(unsigned, b); }
__device__ __forceinline__ float bflo(unsigned w) { return __builtin_bit_cast(float, w << 16); }
__device__ __forceinline__ float bfhi(unsigned w) { return __builtin_bit_cast(float, w & 0xffff0000u); }
__device__ __forceinline__ float sigmoidf_(float x) { return __builtin_amdgcn_rcpf(1.f + __expf(-x)); }
typedef int v8i __attribute__((ext_vector_type(8)));
typedef int v6i __attribute__((ext_vector_type(6)));
typedef int v2i_ __attribute__((ext_vector_type(2)));
typedef float f32x16_ __attribute__((ext_vector_type(16)));
typedef unsigned v6u __attribute__((ext_vector_type(6)));
typedef int v4i __attribute__((ext_vector_type(4)));
__device__ __forceinline__ float clamp448(float x) { return __builtin_amdgcn_fmed3f(x, -448.f, 448.f); }
__device__ __forceinline__ unsigned pk4_fp8(float a, float b, float c, float d) {
    int w = 0; w = __builtin_amdgcn_cvt_pk_fp8_f32(clamp448(a), clamp448(b), w, false); w = __builtin_amdgcn_cvt_pk_fp8_f32(clamp448(c), clamp448(d), w, true); return (unsigned)w; }
constexpr bool OUTPROJ_FP8 = true;
constexpr bool MOE1_FP6 = true;
constexpr float SC_H6 = 1.f, SC_W6 = 64.f;
constexpr float SC_H = 8.f, SC_W = 256.f, SC_ACT = 4.f, SC_Y = 16.f, SC_MIX = 16.f, SC_WO = 256.f;
__device__ __forceinline__ float wave_sum(float v) {
#pragma unroll
    for (int o = 1; o < 64; o <<= 1) v += __shfl_xor(v, o);
    return v;
}
__device__ __forceinline__ v6u pk32_fp6(const f32x16_ lo, const f32x16_ hi) { return __builtin_amdgcn_cvt_scalef32_2xpk16_fp6_f32(lo, hi, 1.0f); }


namespace pg8 {
constexpr int BM = 256, BK = 64, HALF = 128, HTB = HALF * BK * 2, STAGE_BYTES = 8 * HTB, NXCD = 8, WGM = 8;
__host__ __device__ __forceinline__ int lds_byte(int r, int c) { const int st = (r >> 4) * 2 + (c >> 5), rr = r & 15, cc = c & 31, ob = rr * 64 + cc * 2; return st * 1024 + (ob ^ (((ob >> 9) & 1) << 5)); }
__host__ __device__ __forceinline__ void stage_rc(int b, int& R, int& C) { const int st = b / 1024, sb = b % 1024, swz = sb ^ (((sb >> 9) & 1) << 5); R = (st >> 1) * 16 + swz / 64; C = (st & 1) * 32 + (swz % 64) / 2; }
__host__ __device__ __forceinline__ int perm32(int rho) { const int n = rho >> 4, i = rho & 15; return 8 * (i >> 2) + 4 * n + (i & 3); }

struct Unit { int pm, pn, e, lt, nv; };
struct Gemm { const bf16* A; const bf16* Bt; int M, N, K; size_t bstride; const int* rowlist; };

struct StaticOrder {
    int nM, nN, nwg, G, c;
    __host__ __device__ void init(int M, int N, int G_, int c_) { nM = M / BM; nN = N / BM; nwg = nM * nN; G = G_; c = c_; }
    __host__ __device__ bool next(int i, Unit& u) const {
        const long L = (long)i * G + c; if (L >= nwg) return false;
        int wgid = (int)L; { const int q = nwg / NXCD, r = nwg % NXCD, xcd = wgid % NXCD, off = wgid / NXCD; wgid = (xcd < r ? xcd * (q + 1) : r * (q + 1) + (xcd - r) * q) + off; }
        const int nig = WGM * nN, gid = wgid / nig, fm = gid * WGM, gsz = (nM - fm) < WGM ? (nM - fm) : WGM;
        u.pm = fm + ((wgid % nig) % gsz); u.pn = (wgid % nig) / gsz; u.e = 0; u.lt = 0; u.nv = 256; return true;
    }
};
struct MoeOrder {
    const LAS int* tb; const LAS int* cn; const LAS int* te; int NP, G, vc, ntiles; bool rev = false;
    __device__ __forceinline__ int chunk_tiles() const { return (ntiles + 7) / 8; }
    __device__ __forceinline__ int xcd_units(int x) const { const int Ct = chunk_tiles(); int t = ntiles - x * Ct; t = t < 0 ? 0 : (t > Ct ? Ct : t); return t * NP; }
    __device__ __forceinline__ bool next(int i, Unit& u) const {
        int T, pn;
        if (G % 8 == 0) { const int R = G / 8, x = vc / R, j = vc % R; const int off = i * R + j; const int xu = xcd_units(x); if (off >= xu) return false; const int tl = off / NP; T = x * chunk_tiles() + (rev ? xu / NP - 1 - tl : tl); pn = off % NP; }
        else { const long L = (long)i * G + vc; if (L >= (long)ntiles * NP) return false; T = (int)(L / NP); if (rev) T = ntiles - 1 - T; pn = (int)(L % NP); }
        const int e = te[T];
        const int mt = T - tb[e]; int nv = cn[e] - mt * 256; nv = nv > 256 ? 256 : nv;
        u.pm = __builtin_amdgcn_readfirstlane(T); u.pn = __builtin_amdgcn_readfirstlane(pn); u.e = __builtin_amdgcn_readfirstlane(e);
        u.lt = __builtin_amdgcn_readfirstlane(e * LIST_CAP + mt * 256); u.nv = __builtin_amdgcn_readfirstlane(nv); return true;
    }
    __device__ __forceinline__ int idle_in_last_round(int* rank) const {
        *rank = -1;
        if (G % 8 != 0) { const long U = (long)ntiles * NP; const int nr = (int)((U + G - 1) / G); const int idle = (int)((long)nr * G - U); if (vc >= G - idle) *rank = vc - (G - idle); return idle; }
        const int R = G / 8, x = vc / R, j = vc % R; const int nr = (xcd_units(0) + R - 1) / R; int total = 0;
        for (int xx = 0; xx < 8; ++xx) { int busy = xcd_units(xx) - (nr - 1) * R; busy = busy < 0 ? 0 : (busy > R ? R : busy);
            if (xx == x && j >= busy) *rank = total + (j - busy);
            total += R - busy; }
        return total;
    }
};

__device__ __forceinline__ unsigned cvt_pk_bf16(float lo, float hi) { unsigned r; asm volatile("v_cvt_pk_bf16_f32 %0, %1, %2" : "=v"(r) : "v"(lo), "v"(hi)); return r; }

struct EpiProj {
    static constexpr bool PERM = true, SLOTS = false;
    bf16* O; const float* bias; const float* hglb; float s;
    __device__ __forceinline__ void operator()(const f32x4 (&acc)[2][2][4][2], const Unit& u, int wr, int wc, int fr, int fq) const {
        const int row0 = u.pm * BM + wr * 64 + fr, col0 = u.pn * BM + wc * 32 + 8 * fq;
        const int mode = (u.pn == 3 || u.pn == 4 || u.pn == 9 || u.pn == 10) ? 1 : ((u.pn == 5 || u.pn == 6) ? 2 : 0);
        f32x4 bv[2][2], ol[2][2];
#pragma unroll
        for (int bj = 0; bj < 2; ++bj)
#pragma unroll
            for (int n = 0; n < 2; ++n) { bv[bj][n] = *(const f32x4*)(bias + col0 + bj * HALF + 4 * n); ol[bj][n] = (f32x4){1.f, 1.f, 1.f, 1.f}; }
        if (mode == 2) { f32x4 a0[2][2], a1[2][2];
#pragma unroll
            for (int bj = 0; bj < 2; ++bj)
#pragma unroll
                for (int n = 0; n < 2; ++n) { const int c = col0 + bj * HALF + 4 * n - 1280; a0[bj][n] = *(const f32x4*)(hglb + c); a1[bj][n] = *(const f32x4*)(hglb + 512 + c); }
#pragma unroll
            for (int bj = 0; bj < 2; ++bj)
#pragma unroll
                for (int n = 0; n < 2; ++n)
#pragma unroll
                    for (int e = 0; e < 4; ++e) ol[bj][n][e] = 1.f - __builtin_amdgcn_rcpf(1.f + __expf(a1[bj][n][e] - a0[bj][n][e])); }
#pragma unroll
        for (int ai = 0; ai < 2; ++ai)
#pragma unroll
            for (int m = 0; m < 4; ++m) { bf16* rowp = O + (size_t)(row0 + ai * HALF + m * 16) * 2816 + col0;
#pragma unroll
                for (int bj = 0; bj < 2; ++bj) { f32x4 v0 = acc[ai][bj][m][0] * s + bv[bj][0], v1 = acc[ai][bj][m][1] * s + bv[bj][1];
                    if (mode == 1) {
#pragma unroll
                        for (int e = 0; e < 4; ++e) { v0[e] = v0[e] * __builtin_amdgcn_rcpf(1.f + __expf(-v0[e])); v1[e] = v1[e] * __builtin_amdgcn_rcpf(1.f + __expf(-v1[e])); } }
                    else if (mode == 2) {
#pragma unroll
                        for (int e = 0; e < 4; ++e) { v0[e] = ol[bj][0][e] * __builtin_amdgcn_rcpf(1.f + __expf(v0[e])); v1[e] = ol[bj][1][e] * __builtin_amdgcn_rcpf(1.f + __expf(v1[e])); } }
                    v4u w; w.x = cvt_pk_bf16(v0[0], v0[1]); w.y = cvt_pk_bf16(v0[2], v0[3]); w.z = cvt_pk_bf16(v1[0], v1[1]); w.w = cvt_pk_bf16(v1[2], v1[3]);
                    *(v4u*)(rowp + bj * HALF) = w; } }
    }
};
struct EpiRes {
    static constexpr bool PERM = true, SLOTS = false;
    bf16* O; const float* X; const float* bias; const float* mod; float* SSQ; float s;
    static __device__ __forceinline__ void swap32(f32x4& a, f32x4& b) {
#pragma unroll
        for (int e = 0; e < 4; ++e) { auto rr = __builtin_amdgcn_permlane32_swap(__float_as_uint(a[e]), __float_as_uint(b[e]), false, false); a[e] = __uint_as_float(rr[0]); b[e] = __uint_as_float(rr[1]); }
    }
    __device__ __forceinline__ void operator()(const f32x4 (&acc)[2][2][4][2], const Unit& u, int wr, int wc, int fr, int fq) const {
        const int row0 = u.pm * BM + wr * 64 + fr, col0 = u.pn * BM + wc * 32 + 8 * fq; const int b = (u.pm * BM) >> 12;
        const int colp = u.pn * BM + wc * 32 + (fq & 1) * 8 + (fq >> 1) * 4;
        f32x4 bv[2][2], gv[2][2];
#pragma unroll
        for (int bj = 0; bj < 2; ++bj)
#pragma unroll
            for (int n = 0; n < 2; ++n) { bv[bj][n] = *(const f32x4*)(bias + col0 + bj * HALF + 4 * n); gv[bj][n] = *(const f32x4*)(mod + b * 6144 + 2048 + col0 + bj * HALF + 4 * n); }
#pragma unroll
        for (int ai = 0; ai < 2; ++ai)
#pragma unroll
            for (int mp = 0; mp < 2; ++mp) {
                f32x4 xv[2][2][2];
#pragma unroll
                for (int mm = 0; mm < 2; ++mm) { const size_t ro = (size_t)(row0 + ai * HALF + (2 * mp + mm) * 16) * DM + colp;
#pragma unroll
                    for (int bj = 0; bj < 2; ++bj)
#pragma unroll
                        for (int n = 0; n < 2; ++n) xv[mm][bj][n] = *(const f32x4*)(X + ro + bj * HALF + 16 * n); }
#pragma unroll
                for (int mm = 0; mm < 2; ++mm) { const int m = 2 * mp + mm; const int row = row0 + ai * HALF + m * 16; const size_t ro = (size_t)row * DM + col0; float ss = 0.f;
#pragma unroll
                    for (int bj = 0; bj < 2; ++bj) { swap32(xv[mm][bj][0], xv[mm][bj][1]); f32x4 ov[2];
#pragma unroll
                        for (int n = 0; n < 2; ++n) { ov[n] = xv[mm][bj][n] + gv[bj][n] * (acc[ai][bj][m][n] * s + bv[bj][n]);
                            ss += (ov[n][0] * ov[n][0] + ov[n][1] * ov[n][1]) + (ov[n][2] * ov[n][2] + ov[n][3] * ov[n][3]); }
                        const v4u w = {cvtpk(ov[0][0], ov[0][1]), cvtpk(ov[0][2], ov[0][3]), cvtpk(ov[1][0], ov[1][1]), cvtpk(ov[1][2], ov[1][3])};
                        *(v4u*)(O + ro + bj * HALF) = w; }
                    ss += __shfl_xor(ss, 16); ss += __shfl_xor(ss, 32);
                    if (fq == 0) SSQ[(size_t)row * 16 + u.pn * 4 + wc] = ss; }
            }
    }
};
struct EpiSwiglu {
    static constexpr bool PERM = true, SLOTS = false;
    unsigned char* O; const float* bgu; float s;
    __device__ __forceinline__ void operator()(const f32x4 (&acc)[2][2][4][2], const Unit& u, int wr, int wc, int fr, int fq) const {
        const int row0 = u.pm * BM + wr * 64 + fr, colo = u.pn * HALF + wc * 32 + 8 * fq;
        const float* bp = bgu + (size_t)u.e * 2048 + 2 * colo;
        f32x4 t[4];
#pragma unroll
        for (int i = 0; i < 4; ++i) t[i] = *(const f32x4*)(bp + 4 * i);
        const f32x4 bg0 = {t[0][0], t[0][2], t[1][0], t[1][2]}, bu0 = {t[0][1], t[0][3], t[1][1], t[1][3]};
        const f32x4 bg1 = {t[2][0], t[2][2], t[3][0], t[3][2]}, bu1 = {t[2][1], t[2][3], t[3][1], t[3][3]};
#pragma unroll
        for (int ai = 0; ai < 2; ++ai)
#pragma unroll
            for (int m = 0; m < 4; ++m) {
                unsigned wq[2];
#pragma unroll
                for (int n = 0; n < 2; ++n) { f32x4 g4 = acc[ai][0][m][n] * s + (n ? bg1 : bg0), u4 = acc[ai][1][m][n] * s + (n ? bu1 : bu0);
                    g4 = __builtin_elementwise_min(g4, (f32x4){7.f, 7.f, 7.f, 7.f}); u4 = __builtin_elementwise_min(__builtin_elementwise_max(u4, (f32x4){-7.f, -7.f, -7.f, -7.f}), (f32x4){7.f, 7.f, 7.f, 7.f});
                    const f32x4 z = g4 * (-1.702f * 1.4426950408889634f); f32x4 sg;
#pragma unroll
                    for (int i = 0; i < 4; ++i) sg[i] = __builtin_amdgcn_rcpf(1.f + __builtin_amdgcn_exp2f(z[i]));
                    const f32x4 a = (u4 + 1.f) * (g4 * SC_ACT) * sg;
                    int w = 0; w = __builtin_amdgcn_cvt_pk_fp8_f32(a[0], a[1], w, false); w = __builtin_amdgcn_cvt_pk_fp8_f32(a[2], a[3], w, true); wq[n] = (unsigned)w; }
                v2u w; w.x = wq[0]; w.y = wq[1];
                *(v2u*)(O + (size_t)(row0 + ai * HALF + m * 16) * DFF + colo) = w; }
    }
};
struct EpiScatter {
    static constexpr bool PERM = true, SLOTS = false;
    unsigned char* O; float s; const float* bd;
    __device__ __forceinline__ void operator()(const f32x4 (&acc)[2][2][4][2], const Unit& u, int wr, int wc, int fr, int fq) const {
        const int row0 = u.pm * BM + wr * 64 + fr, col0 = u.pn * BM + wc * 32 + 8 * fq;
        f32x4 bv[2][2];
#pragma unroll
        for (int bj = 0; bj < 2; ++bj)
#pragma unroll
            for (int n = 0; n < 2; ++n) bv[bj][n] = *(const f32x4*)(bd + (size_t)u.e * DM + col0 + bj * HALF + 4 * n) * SC_Y;
#pragma unroll
        for (int ai = 0; ai < 2; ++ai)
#pragma unroll
            for (int m = 0; m < 4; ++m) { unsigned char* rowp = O + (size_t)(row0 + ai * HALF + m * 16) * DM + col0;
#pragma unroll
                for (int bj = 0; bj < 2; ++bj) { const f32x4 v0 = acc[ai][bj][m][0] * s + bv[bj][0], v1 = acc[ai][bj][m][1] * s + bv[bj][1];
                    v2u w; w.x = pk4_fp8(v0[0], v0[1], v0[2], v0[3]); w.y = pk4_fp8(v1[0], v1[1], v1[2], v1[3]);
                    *(v2u*)(rowp + bj * HALF) = w; } }
    }
};

template <bool FP6> struct FragT { typedef v8i type; };
template <> struct FragT<true> { typedef v6i type; };
template <bool FP6> __device__ __forceinline__ typename FragT<FP6>::type ld_frag(const LAS unsigned char* p) {
    if constexpr (FP6) { const v4i a = *(const LAS v4i*)p; const v2i_ b = *(const volatile LAS v2i_*)(p + 1024);        return (v6i){a[0], a[1], a[2], a[3], b[0], b[1]}; }
    else return __builtin_shufflevector(*(const LAS v4i*)p, *(const LAS v4i*)(p + 1024), 0, 1, 2, 3, 4, 5, 6, 7);
}
template <class Epi, class Sched, bool ALIGN_EPI, bool GATHER, bool FP8 = false, bool FP6 = false>
__device__ __forceinline__ void gemm_phase(LAS unsigned char* lds, const Gemm g, const Sched& S, const Epi& E) {
    const int tid = threadIdx.x, wid = __builtin_amdgcn_readfirstlane(tid >> 6), lane = tid & 63, wr = wid >> 2, wc = wid & 3, fr = lane & 15, fq = lane >> 4;
    const int K = g.K, nt = K / BK;
    unsigned voffA[2], voffB[2]; int RA[2], CA[2];
#pragma unroll
    for (int i = 0; i < 2; ++i) { int R, C; stage_rc(tid * 16 + i * 8192, R, C); const int Rb = Epi::PERM ? ((R & ~31) + perm32(R & 31)) : R;
        RA[i] = R; CA[i] = C; voffA[i] = (unsigned)(R * K + C) * 2u; voffB[i] = (unsigned)(Rb * K + C) * 2u; }
    const size_t kstep = (size_t)(BK * 2);
    const size_t hstep = (size_t)HALF * K * 2;
    const size_t tstep = 2 * hstep;
    const unsigned ldsw = (unsigned)wid * 1024u;
    const int aoff = lds_byte(wr * 64 + fr, fq * 8), boff = lds_byte(wc * 32 + fr, fq * 8);
#define PG8_SA(b, h) (((b) * 2 + (h)) * HTB)
#define PG8_SB(b, h) ((4 + (b) * 2 + (h)) * HTB)
#define PG8_STAGE(bufoff, gbase, voff) do { _Pragma("unroll") for (int _i = 0; _i < 2; ++_i) \
        __builtin_amdgcn_global_load_lds((const unsigned*)((const char*)(gbase) + (voff)[_i]), (LAS unsigned*)(lds + (bufoff) + ldsw + _i * 8192), 16, 0, 0); } while (0)
#define PG8_STAGE_A(bufoff, kptr, h, VV, UU) do { if constexpr (GATHER) PG8_STAGE(bufoff, kptr, VV[h]); else PG8_STAGE(bufoff, (kptr) + (UU) + (size_t)(h) * hstep, voffA); } while (0)
#define PG8_LD8(p) ld_frag<FP6>(p)
#define PG8_LDA(dst, b, h) do { _Pragma("unroll") for (int m = 0; m < 4; ++m) { if constexpr (FP8) dst##8[m] = PG8_LD8(lds + PG8_SA(b, h) + aoff + m * 2048); \
        else { _Pragma("unroll") for (int k = 0; k < 2; ++k) dst[m][k] = *(const LAS bf16x8*)(lds + PG8_SA(b, h) + aoff + m * 2048 + k * 1024); } } } while (0)
#define PG8_LDB(dst, b, h) do { _Pragma("unroll") for (int n = 0; n < 2; ++n) { if constexpr (FP8) dst##8[n] = PG8_LD8(lds + PG8_SB(b, h) + boff + n * 2048); \
        else { _Pragma("unroll") for (int k = 0; k < 2; ++k) dst[n][k] = *(const LAS bf16x8*)(lds + PG8_SB(b, h) + boff + n * 2048 + k * 1024); } } } while (0)
#define PG8_MMA(ai, bj, At, Bt) do { __builtin_amdgcn_s_setprio(1); _Pragma("unroll") for (int m = 0; m < 4; ++m) _Pragma("unroll") for (int n = 0; n < 2; ++n) { \
        if constexpr (FP6) asm volatile("v_mfma_scale_f32_16x16x128_f8f6f4 %0, %1, %2, %0, %3, %3 op_sel_hi:[0,0,0] cbsz:2 blgp:2" : "+v"(acc[ai][bj][m][n]) : "v"(Bt##8[n]), "v"(At##8[m]), "v"(sc1)); \
        else if constexpr (FP8) asm volatile("v_mfma_scale_f32_16x16x128_f8f6f4 %0, %1, %2, %0, %3, %3 op_sel_hi:[0,0,0]" : "+v"(acc[ai][bj][m][n]) : "v"(Bt##8[n]), "v"(At##8[m]), "v"(sc1)); \
        else { _Pragma("unroll") for (int k = 0; k < 2; ++k) acc[ai][bj][m][n] = __builtin_amdgcn_mfma_f32_16x16x32_bf16(Bt[n][k], At[m][k], acc[ai][bj][m][n], 0, 0, 0); } } __builtin_amdgcn_s_setprio(0); } while (0)
#define PG8_WAIT_V(n) asm volatile("s_waitcnt vmcnt(" #n ")" ::: "memory")
#define PG8_WAIT_L(n) asm volatile("s_waitcnt lgkmcnt(" #n ")" ::: "memory")
#define PG8_BAR __builtin_amdgcn_s_barrier()
#define PG8_SCHED __builtin_amdgcn_sched_barrier(0)
#define PG8_AOFFS(v, u) do { _Pragma("unroll") for (int _h = 0; _h < 2; ++_h) _Pragma("unroll") for (int _i = 0; _i < 2; ++_i) { \
        if (GATHER) { const int _r = _h * HALF + RA[_i]; const int _row = g.rowlist[(u).lt + (_r < (u).nv ? _r : 0)] >> 2; v[_h][_i] = (unsigned)(_row * K + CA[_i]) * 2u; } \
        else v[_h][_i] = 0u; } } while (0)
    Unit cur, nxt, nn; int ui = 0;
    if (!S.next(0, cur)) return;
    bool has_next = S.next(1, nxt);
    f32x4 acc[2][2][4][2];
#pragma unroll
    for (int a = 0; a < 2; ++a)
#pragma unroll
        for (int b = 0; b < 2; ++b)
#pragma unroll
            for (int m = 0; m < 4; ++m)
#pragma unroll
                for (int n = 0; n < 2; ++n) acc[a][b][m][n] = (f32x4){0.f, 0.f, 0.f, 0.f};
    bf16x8 At[4][2], B0[2][2], B1[2][2]; typename FragT<FP6>::type At8[4], B08[2], B18[2]; const int sc1 = 0x7f7f7f7f;
    unsigned vC[2][2], vN[2][2]; int slot[8];
    PG8_AOFFS(vC, cur);
    if (has_next) { PG8_AOFFS(vN, nxt); } else {
#pragma unroll
        for (int h = 0; h < 2; ++h)
#pragma unroll
            for (int i = 0; i < 2; ++i) vN[h][i] = vC[h][i]; }
    const char* const Ab = (const char*)g.A;
    size_t uC = (size_t)cur.pm * tstep, uN = has_next ? (size_t)nxt.pm * tstep : uC;
    const char* cB = (const char*)g.Bt + ((size_t)cur.e * g.bstride) * 2 + (size_t)cur.pn * tstep;
    PG8_STAGE(PG8_SB(0, 0), cB, voffB); PG8_STAGE(PG8_SB(0, 1), cB + hstep, voffB); PG8_STAGE_A(PG8_SA(0, 0), Ab, 0, vC, uC); PG8_STAGE_A(PG8_SA(0, 1), Ab, 1, vC, uC);
    if (wr == 1) PG8_BAR;
    PG8_WAIT_V(2); PG8_BAR;
    PG8_STAGE(PG8_SB(1, 0), cB + kstep, voffB); PG8_STAGE_A(PG8_SA(1, 0), Ab + kstep, 0, vC, uC); PG8_STAGE(PG8_SB(1, 1), cB + hstep + kstep, voffB);
    PG8_WAIT_V(6); PG8_BAR;
    for (;;) {
        const bool has_nn = has_next && S.next(ui + 2, nn);
        int rNN[2][2];
#pragma unroll
        for (int h = 0; h < 2; ++h)
#pragma unroll
            for (int i = 0; i < 2; ++i) { rNN[h][i] = 0; if (GATHER) { const int lt_ = has_nn ? nn.lt : cur.lt, nv_ = has_nn ? nn.nv : cur.nv; const int r = h * HALF + RA[i]; rNN[h][i] = g.rowlist[lt_ + (r < nv_ ? r : 0)]; } }
        if constexpr (Epi::SLOTS) E.prefetch(slot, cur, wr, fr);
        const char* nB = has_next ? (const char*)g.Bt + ((size_t)nxt.e * g.bstride) * 2 + (size_t)nxt.pn * tstep : cB;
        for (int t = 0; t < nt; t += 2) {
            const bool last = (t == nt - 2);
            const char* a1 = Ab + (size_t)(t + 1) * kstep;
            const char* a2 = last ? Ab : Ab + (size_t)(t + 2) * kstep; const char* b2 = last ? nB : cB + (size_t)(t + 2) * kstep;
            const char* a3 = a2 + kstep; const char* b3 = b2 + kstep;
            unsigned v2[2][2]; const size_t u2 = last ? uN : uC;
#pragma unroll
            for (int h = 0; h < 2; ++h)
#pragma unroll
                for (int i = 0; i < 2; ++i) v2[h][i] = last ? vN[h][i] : vC[h][i];
            PG8_LDB(B0, 0, 0); PG8_LDB(B1, 0, 1); PG8_SCHED; PG8_LDA(At, 0, 0); PG8_STAGE_A(PG8_SA(1, 1), a1, 1, vC, uC);
            PG8_WAIT_V(8); PG8_WAIT_L(0); PG8_BAR; PG8_MMA(0, 0, At, B0); PG8_MMA(0, 1, At, B1); PG8_BAR; PG8_SCHED;
            PG8_LDA(At, 0, 1); PG8_STAGE(PG8_SB(0, 0), b2, voffB); PG8_STAGE(PG8_SB(0, 1), b2 + hstep, voffB); PG8_STAGE_A(PG8_SA(0, 0), a2, 0, v2, u2);
            PG8_WAIT_V(8); PG8_WAIT_L(0); PG8_BAR; PG8_MMA(1, 0, At, B0); PG8_MMA(1, 1, At, B1); PG8_BAR; PG8_SCHED;
            PG8_LDB(B0, 1, 0); PG8_LDB(B1, 1, 1); PG8_SCHED; PG8_LDA(At, 1, 0); PG8_STAGE_A(PG8_SA(0, 1), a2, 1, v2, u2);
            PG8_WAIT_V(8); PG8_WAIT_L(0); PG8_BAR; PG8_MMA(0, 0, At, B0); PG8_MMA(0, 1, At, B1); PG8_BAR; PG8_SCHED;
            PG8_LDA(At, 1, 1); PG8_STAGE(PG8_SB(1, 0), b3, voffB); PG8_STAGE(PG8_SB(1, 1), b3 + hstep, voffB); PG8_STAGE_A(PG8_SA(1, 0), a3, 0, v2, u2);
            PG8_WAIT_V(8); PG8_WAIT_L(0); PG8_BAR; PG8_MMA(1, 0, At, B0); PG8_MMA(1, 1, At, B1); PG8_BAR; PG8_SCHED;
        }
        if constexpr (ALIGN_EPI) { if (wr == 0) PG8_BAR; }
        if constexpr (FP8) asm volatile("s_nop 15\n\ts_nop 15" ::: "memory");
        if constexpr (Epi::SLOTS) E(acc, cur, wr, wc, fr, fq, slot); else E(acc, cur, wr, wc, fr, fq);
        if (!has_next) break;
#pragma unroll
        for (int a = 0; a < 2; ++a)
#pragma unroll
            for (int b = 0; b < 2; ++b)
#pragma unroll
                for (int m = 0; m < 4; ++m)
#pragma unroll
                    for (int n = 0; n < 2; ++n) acc[a][b][m][n] = (f32x4){0.f, 0.f, 0.f, 0.f};
        cur = nxt; nxt = nn; has_next = has_nn; cB = nB; ++ui; uC = uN; if (has_next) uN = (size_t)nxt.pm * tstep;
#pragma unroll
        for (int h = 0; h < 2; ++h)
#pragma unroll
            for (int i = 0; i < 2; ++i) { vC[h][i] = vN[h][i]; if (GATHER) asm volatile("" : "+v"(rNN[h][i]));
                if (GATHER && has_next) vN[h][i] = (unsigned)((rNN[h][i] >> 2) * K + CA[i]) * 2u; }
        if constexpr (ALIGN_EPI) { if (wr == 1) PG8_BAR; }
    }
    PG8_WAIT_V(0);
    if constexpr (!ALIGN_EPI) { if (wr == 0) PG8_BAR; }
    PG8_BAR;
#undef PG8_SA
#undef PG8_SB
#undef PG8_STAGE
#undef PG8_LDA
#undef PG8_LDB
#undef PG8_MMA
#undef PG8_LD8
#undef PG8_STAGE_A
#undef PG8_WAIT_V
#undef PG8_WAIT_L
#undef PG8_BAR
#undef PG8_SCHED
#undef PG8_AOFFS
}
}

#define XB_TMO      128
#define XB_XCNT(j)  (256  + 64 * (j))
#define XB_XSUB(j)  (1280 + 64 * (j))
#define XB_XGEN(j)  (2304 + 64 * (j))
#define XB_TOP      3328
#define XB_TOPGEN   3392
#define XCD_BAR_WORDS 3456
#define XB_SPIN_CAP (1u << 22)
__device__ __forceinline__ unsigned xb_ld(unsigned* p)              { return __hip_atomic_load(p, __ATOMIC_RELAXED, __HIP_MEMORY_SCOPE_AGENT); }
__device__ __forceinline__ unsigned xb_add(unsigned* p, unsigned v) { return __hip_atomic_fetch_add(p, v, __ATOMIC_RELAXED, __HIP_MEMORY_SCOPE_AGENT); }
__device__ __forceinline__ unsigned xb_xcc_id() { return (unsigned)__builtin_amdgcn_s_getreg((3 << 11) | 20) & 0xFu; }
#define XB_SPIN(cond, bar) do { unsigned _sp = 0; while (cond) { __builtin_amdgcn_s_sleep(1); \
    if ((++_sp & 255u) == 0u) { if (xb_ld(&(bar)[XB_TMO])) break; if (_sp > XB_SPIN_CAP) { atomicAdd(&(bar)[XB_TMO], 1u); break; } } } } while (0)
struct XcdBarrier { unsigned* bar; unsigned x; volatile LAS unsigned* st; };
__device__ __forceinline__ XcdBarrier xcd_barrier_post(unsigned* bar, volatile LAS unsigned* st) {
    XcdBarrier b; b.bar = bar; b.x = xb_xcc_id(); b.st = st;
    if (threadIdx.x == 0) (void)xb_add(&bar[XB_XCNT(b.x)], 1u);
    return b;
}
__device__ __forceinline__ void xcd_barrier_complete(unsigned* bar, unsigned x, unsigned& nloc, unsigned& nx) {
    const unsigned G = gridDim.x * gridDim.y * gridDim.z;
    unsigned sum, cnt, mine, sp = 0u;
    for (;;) {
        sum = 0u; cnt = 0u; mine = 0u;
#pragma unroll
        for (unsigned j = 0; j < 16; ++j) { const unsigned c = xb_ld(&bar[XB_XCNT(j)]); sum += c; cnt += (c > 0u) ? 1u : 0u; mine = (j == x) ? c : mine; }
        if (sum == G) break;
        __builtin_amdgcn_s_sleep(1);
        if ((++sp & 255u) == 0u) { if (xb_ld(&bar[XB_TMO])) break; if (sp > XB_SPIN_CAP) { atomicAdd(&bar[XB_TMO], 1u); break; } }
    }
    nloc = mine > 0u ? mine : 1u; nx = cnt > 0u ? cnt : 1u;
}
__device__ __forceinline__ void xcd_barrier(const XcdBarrier& b) {
    asm volatile("s_waitcnt vmcnt(0)" ::: "memory");
    __syncthreads();
    if (threadIdx.x == 0) {
        unsigned* bar = b.bar;
        __builtin_amdgcn_s_waitcnt(0);
        unsigned nloc = b.st[0], nx = b.st[1];
        if (nloc == 0u) { xcd_barrier_complete(bar, b.x, nloc, nx); b.st[0] = nloc; b.st[1] = nx; }
        const unsigned old = xb_add(&bar[XB_XSUB(b.x)], 1u);
        const unsigned gen = old / nloc;
        if (old + 1u == (gen + 1u) * nloc) {
            __builtin_amdgcn_fence(__ATOMIC_RELEASE, "agent");
            asm volatile("s_waitcnt vmcnt(0)" ::: "memory");
            const unsigned og = xb_add(&bar[XB_TOP], 1u);
            const unsigned tg = og / nx;
            if (og + 1u == (tg + 1u) * nx) xb_add(&bar[XB_TOPGEN], 1u);
            else XB_SPIN(xb_ld(&bar[XB_TOPGEN]) == tg, bar);
            __builtin_amdgcn_fence(__ATOMIC_ACQUIRE, "agent");
            xb_add(&bar[XB_XGEN(b.x)], 1u);
            asm volatile("s_waitcnt vmcnt(0)" ::: "memory");
        } else {
            XB_SPIN(xb_ld(&bar[XB_XGEN(b.x)]) == gen, bar);
            __builtin_amdgcn_fence(__ATOMIC_ACQUIRE, "agent");
            asm volatile("s_waitcnt vmcnt(0)" ::: "memory");
        }
    }
    __syncthreads();
}

struct Args { const float* in[21]; float* out; unsigned char* ws; int ph_lo, ph_hi; };
struct Ctx {
    LAS unsigned char* lds; int tid, lane, wave, vcu, G;
};

template <bool GU>
__device__ __forceinline__ void p0_transpose_item(const float* W, int K, int N, bf16* WT, LAS float* scr, int item, int lane) {
    const int nblk = N / 32, kb = item / nblk, nb = item % nblk, k0 = 64 * kb, n0 = 32 * nb;
    float ld[32];
#pragma unroll
    for (int i = 0; i < 32; ++i) ld[i] = W[(size_t)(k0 + 2 * i + (lane >> 5)) * N + n0 + (lane & 31)];
#pragma unroll
    for (int i = 0; i < 32; ++i) scr[(2 * i + (lane >> 5)) * 33 + (lane & 31)] = ld[i];
    LDS_WAIT(); asm volatile("" ::: "memory");
    const int c = lane & 7;
#pragma unroll
    for (int j = 0; j < 4; ++j) { const int n = (lane >> 3) + 8 * j; const LAS float* s = scr + (8 * c) * 33 + n;
        v4u o; o.x = pk2(s[0 * 33], s[1 * 33]); o.y = pk2(s[2 * 33], s[3 * 33]); o.z = pk2(s[4 * 33], s[5 * 33]); o.w = pk2(s[6 * 33], s[7 * 33]);
        const int col = n0 + n; int row = col;
        if (GU) { const int jj = col >> 1, sg = col & 1; row = (jj >> 7) * 256 + sg * 128 + (jj & 127); }
        *(GAS v4u*)(WT + (size_t)row * K + k0 + 8 * c) = o; }
    LDS_WAIT(); asm volatile("" ::: "memory");
}
template <bool GU>
__device__ __forceinline__ void p0_transpose_item8(const float* W, int K, int N, unsigned char* WT, LAS float* scr, int item, int lane) {
    const int nblk = N / 32, kb = item / nblk, nb = item % nblk, k0 = 128 * kb, n0 = 32 * nb;
#pragma unroll
    for (int hf = 0; hf < 2; ++hf) {
        float ld[32];
#pragma unroll
        for (int i = 0; i < 32; ++i) ld[i] = W[(size_t)(k0 + 64 * hf + 2 * i + (lane >> 5)) * N + n0 + (lane & 31)];
#pragma unroll
        for (int i = 0; i < 32; ++i) scr[(64 * hf + 2 * i + (lane >> 5)) * 33 + (lane & 31)] = ld[i];
    }
    LDS_WAIT(); asm volatile("" ::: "memory");
    const int c = lane & 7;
#pragma unroll
    for (int j = 0; j < 4; ++j) { const int n = (lane >> 3) + 8 * j; const LAS float* s = scr + (16 * c) * 33 + n;
        v4u o;
        o.x = pk4_fp8(s[0 * 33] * SC_W, s[1 * 33] * SC_W, s[2 * 33] * SC_W, s[3 * 33] * SC_W); o.y = pk4_fp8(s[4 * 33] * SC_W, s[5 * 33] * SC_W, s[6 * 33] * SC_W, s[7 * 33] * SC_W);
        o.z = pk4_fp8(s[8 * 33] * SC_W, s[9 * 33] * SC_W, s[10 * 33] * SC_W, s[11 * 33] * SC_W); o.w = pk4_fp8(s[12 * 33] * SC_W, s[13 * 33] * SC_W, s[14 * 33] * SC_W, s[15 * 33] * SC_W);
        const int col = n0 + n; int row = col;
        if (GU) { const int jj = col >> 1, sg = col & 1; row = (jj >> 7) * 256 + sg * 128 + (jj & 127); }
        *(GAS v4u*)(WT + (size_t)row * K + k0 + 16 * c) = o; }
    LDS_WAIT(); asm volatile("" ::: "memory");
}
__device__ __forceinline__ void p0_gu_tile_load(f32x4 (&pre)[8], const float* W, int kb, int nb, int wave, int lane) {
#pragma unroll
    for (int i = 0; i < 8; ++i) pre[i] = *(const f32x4*)(W + (size_t)(128 * kb + 16 * wave + 2 * i + (lane >> 5)) * 2048 + 128 * nb + 4 * (lane & 31));
}
__device__ __forceinline__ void p0_gu_tile_store(const f32x4 (&pre)[8], unsigned char* WT, int kb, int nb, LAS float* scr, int wave, int lane) {
#pragma unroll
    for (int i = 0; i < 8; ++i) { LAS float* d = scr + (16 * wave + 2 * i + (lane >> 5)) * 129 + 4 * (lane & 31); d[0] = pre[i][0]; d[1] = pre[i][1]; d[2] = pre[i][2]; d[3] = pre[i][3]; }
    LDS_BARRIER();
    if constexpr (MOE1_FP6) {
        const int q = lane & 3, n = 16 * wave + (lane >> 2); const LAS float* s = scr + (32 * q) * 129 + n;
        f32x16_ lo, hi;
#pragma unroll
        for (int i = 0; i < 16; ++i) { lo[i] = s[i * 129] * SC_W6; hi[i] = s[(16 + i) * 129] * SC_W6; }
        const v6u o = pk32_fp6(lo, hi);
        const int col = 128 * nb + n, jj = col >> 1, sg = col & 1, row = (jj >> 7) * 256 + sg * 128 + (jj & 127);
        unsigned char* d = WT + (size_t)row * DM + 128 * kb + 16 * q;
        *(GAS v4u*)d = (v4u){o[0], o[1], o[2], o[3]}; *(GAS v2u*)(d + 64) = (v2u){o[4], o[5]};
        LDS_BARRIER(); return; }
    const int c = lane & 7;
#pragma unroll
    for (int j = 0; j < 2; ++j) { const int n = 16 * wave + (lane >> 3) + 8 * j; const LAS float* s = scr + (16 * c) * 129 + n;
        v4u o;
        o.x = pk4_fp8(s[0 * 129] * SC_W, s[1 * 129] * SC_W, s[2 * 129] * SC_W, s[3 * 129] * SC_W); o.y = pk4_fp8(s[4 * 129] * SC_W, s[5 * 129] * SC_W, s[6 * 129] * SC_W, s[7 * 129] * SC_W);
        o.z = pk4_fp8(s[8 * 129] * SC_W, s[9 * 129] * SC_W, s[10 * 129] * SC_W, s[11 * 129] * SC_W); o.w = pk4_fp8(s[12 * 129] * SC_W, s[13 * 129] * SC_W, s[14 * 129] * SC_W, s[15 * 129] * SC_W);
        const int col = 128 * nb + n, jj = col >> 1, sg = col & 1, row = (jj >> 7) * 256 + sg * 128 + (jj & 127);
        *(GAS v4u*)(WT + (size_t)row * DM + 128 * kb + 16 * c) = o; }
    LDS_BARRIER();
}
constexpr int TAIL_EXP = 14, TAIL_B = 9;
__device__ __forceinline__ int inproj_idle_wgs(int G) { const int nwg = (NTOK / 256) * (INC / 256); const int nr = (nwg + G - 1) / G; return nr * G - nwg; }
__device__ __forceinline__ bool tail_enabled(int G) { return inproj_idle_wgs(G) >= 64; }
__device__ __forceinline__ void phase_prologue(const Ctx& F, const Args& A) {
    unsigned char* ws = A.ws;
    {
        LAS float* sck = (LAS float*)F.lds;
        LAS float* part = sck + 8192;
        const float* c = A.in[1]; const float* wada = A.in[2]; const float* bada = A.in[3]; float* mod = (float*)(ws + WS_MOD);
        bool did = false;
        for (int cb = blockIdx.x; cb < 96; cb += F.G) {
            if (!did) { for (int i = F.tid; i < 8192; i += 512) { const int b = i >> 10, k = i & 1023; const float v = c[i]; sck[k * 8 + b] = v * sigmoidf_(v); } did = true; }
            __syncthreads();
            const int n = cb * 64 + F.lane; float acc[8];
#pragma unroll
            for (int b = 0; b < 8; ++b) acc[b] = 0.f;
#pragma unroll 32
            for (int kk = 0; kk < 128; ++kk) { const int k = F.wave * 128 + kk; const float wv = wada[(size_t)k * 6144 + n];
                const f32x4 s0 = *(const LAS f32x4*)(sck + k * 8), s1 = *(const LAS f32x4*)(sck + k * 8 + 4);
                acc[0] += s0[0] * wv; acc[1] += s0[1] * wv; acc[2] += s0[2] * wv; acc[3] += s0[3] * wv; acc[4] += s1[0] * wv; acc[5] += s1[1] * wv; acc[6] += s1[2] * wv; acc[7] += s1[3] * wv; }
#pragma unroll
            for (int b = 0; b < 8; ++b) part[(F.wave * 8 + b) * 64 + F.lane] = acc[b];
            __syncthreads();
            { const int b = F.tid >> 6; float s = 0.f;
#pragma unroll
              for (int w = 0; w < 8; ++w) s += part[(w * 8 + b) * 64 + F.lane];
              mod[b * 6144 + n] = s + bada[n]; }
            __syncthreads();
        }
        __syncthreads();
    }
    {
        const float* wr = A.in[14]; v4u* wrf = (v4u*)(ws + WS_WRF);
        for (int i = blockIdx.x * 512 + F.tid; i < 32 * 2 * 64; i += F.G * 512) {
            const int lane = i & 63, nt = (i >> 6) & 1, s = i >> 7, q = lane >> 4, e = (lane & 15) + 16 * nt;
            float hi[8], lo[8];
#pragma unroll
            for (int j = 0; j < 8; ++j) { const float w = wr[(size_t)(MOE1_FP6 ? 128 * (s >> 2) + 32 * q + 8 * (s & 3) + j : 32 * s + 8 * q + j) * 32 + e];   const float h = bf2f(f2bf(w)); hi[j] = h; lo[j] = w - h; }
            v4u oh, ol; oh.x = pk2(hi[0], hi[1]); oh.y = pk2(hi[2], hi[3]); oh.z = pk2(hi[4], hi[5]); oh.w = pk2(hi[6], hi[7]);
            ol.x = pk2(lo[0], lo[1]); ol.y = pk2(lo[2], lo[3]); ol.z = pk2(lo[4], lo[5]); ol.w = pk2(lo[6], lo[7]);
            wrf[((s * 2 + nt) * 2 + 0) * 64 + lane] = oh; wrf[((s * 2 + nt) * 2 + 1) * 64 + lane] = ol;
        }
    }
    {
        LAS float* scr = (LAS float*)(F.lds + F.wave * 16896);
        const int gw = F.vcu * 8 + F.wave, NGW = F.G * 8;
        constexpr int I_IN = (DM / 128) * (INC / 32), I_OUT = (OUTPROJ_FP8 ? DM / 128 : DM / 64) * (DM / 32), I_GU = (DM / 128) * (2048 / 32), I_D = (DFF / 128) * (DM / 32);
        const int ND = (tail_enabled(F.G) ? NEXP - TAIL_EXP - TAIL_B : NEXP) * I_D, NITEMS = I_IN + I_OUT + ND;
        bf16* win = (bf16*)(ws + WS_WIN); bf16* wout = (bf16*)(ws + WS_WOUT); unsigned char* wgu = ws + WS_WGU; unsigned char* wd = ws + WS_WD;
        for (int it = gw; it < NITEMS; it += NGW) {
            int r = it;
            if (r < I_IN) { p0_transpose_item8<false>(A.in[5], DM, INC, (unsigned char*)win, scr, r, F.lane); continue; } r -= I_IN;
            if (r < I_OUT) { if constexpr (OUTPROJ_FP8) p0_transpose_item8<false>(A.in[11], DM, DM, (unsigned char*)wout, scr, r, F.lane); else p0_transpose_item<false>(A.in[11], DM, DM, wout, scr, r, F.lane); continue; } r -= I_OUT;
            { const int e = r / I_D; p0_transpose_item8<false>(A.in[18] + (size_t)e * DFF * DM, DFF, DM, wd + (size_t)e * DM * DFF, scr, r % I_D, F.lane); }
        }
        __syncthreads();
        {
            constexpr int NT = NEXP * 128; const int nmod = F.G < 96 ? F.G : 96;
            int t0, t1;
            { const int skew = 7; const long tot = (long)NT + (long)skew * nmod; const int per = (int)(tot / F.G), rem = (int)(tot % F.G);
              const int bx = blockIdx.x; const long v0 = (long)bx * per + (bx < rem ? bx : rem), v1 = v0 + per + (bx < rem ? 1 : 0);
              const long done_before = (long)(bx < nmod ? bx : nmod) * skew;
              t0 = (int)(v0 - done_before); t1 = (int)(v1 - done_before - (bx < nmod ? skew : 0)); if (t1 < t0) t1 = t0; if (t1 > NT) t1 = NT; if (t0 > NT) t0 = NT; }
            LAS float* tsc = (LAS float*)F.lds;
            f32x4 pre[8];
            if (t0 < t1) { const int e = t0 >> 7, kb = (t0 >> 4) & 7, nb = t0 & 15; p0_gu_tile_load(pre, A.in[16] + (size_t)e * DM * 2048, kb, nb, F.wave, F.lane); }
            for (int t = t0; t < t1; ++t) {
                const int e = t >> 7, kb = (t >> 4) & 7, nb = t & 15;
                f32x4 cur[8];
#pragma unroll
                for (int i = 0; i < 8; ++i) cur[i] = pre[i];
                if (t + 1 < t1) { const int e2 = (t + 1) >> 7, kb2 = ((t + 1) >> 4) & 7, nb2 = (t + 1) & 15; p0_gu_tile_load(pre, A.in[16] + (size_t)e2 * DM * 2048, kb2, nb2, F.wave, F.lane); }
                p0_gu_tile_store(cur, wgu + (size_t)e * 2048 * DM, kb, nb, tsc, F.wave, F.lane);
            }
        }
    }
}
__device__ __forceinline__ void phase_wd_tail(const Ctx& F, const Args& A) {
    if (!tail_enabled(F.G)) return;
    const int idle = inproj_idle_wgs(F.G), first = F.G - idle;
    if ((int)blockIdx.x < first) return;
    LAS float* scr = (LAS float*)(F.lds + F.wave * 16896);
    constexpr int I_D = (DFF / 128) * (DM / 32);
    unsigned char* wd = A.ws + WS_WD;
    for (int it = ((int)blockIdx.x - first) * 8 + F.wave; it < TAIL_EXP * I_D; it += idle * 8) {
        const int e = NEXP - TAIL_EXP + it / I_D;
        p0_transpose_item8<false>(A.in[18] + (size_t)e * DFF * DM, DFF, DM, wd + (size_t)e * DM * DFF, scr, it % I_D, F.lane);
    }
}

__device__ __forceinline__ void phase_wd_tail2(const Ctx& F, const Args& A, const pg8::MoeOrder& S) {
    if (!tail_enabled(F.G)) return;
    int rank; int idle = S.idle_in_last_round(&rank);
    if (idle < 64) { idle = F.G; rank = F.vcu; }
    if (rank < 0) return;
    LAS float* scr = (LAS float*)(F.lds + F.wave * 16896);
    constexpr int I_D = (DFF / 128) * (DM / 32);
    unsigned char* wd = A.ws + WS_WD;
    for (int it = rank * 8 + F.wave; it < TAIL_B * I_D; it += idle * 8) {
        const int e = NEXP - TAIL_EXP - TAIL_B + it / I_D;
        p0_transpose_item8<false>(A.in[18] + (size_t)e * DFF * DM, DFF, DM, wd + (size_t)e * DM * DFF, scr, it % I_D, F.lane);
    }
}

__device__ __forceinline__ void phase_norm1(const Ctx& F, const Args& A) {
    const float* x = A.in[0]; const float* g = A.in[4]; const float* mod = (const float*)(A.ws + WS_MOD); bf16* H = (bf16*)(A.ws + WS_H);
    const int gw = F.vcu * 8 + F.wave, NGW = F.G * 8;
    for (int m0 = 2 * gw; m0 < NTOK; m0 += 2 * NGW) {
        const int b = m0 >> 12;
        f32x4 v[2][4]; float s[2] = {0.f, 0.f};
#pragma unroll
        for (int r = 0; r < 2; ++r) { const f32x4* xr = (const f32x4*)(x + (size_t)(m0 + r) * DM) + F.lane;
#pragma unroll
            for (int j = 0; j < 4; ++j) v[r][j] = xr[64 * j]; }
#pragma unroll
        for (int r = 0; r < 2; ++r)
#pragma unroll
            for (int j = 0; j < 4; ++j) s[r] += (v[r][j][0] * v[r][j][0] + v[r][j][1] * v[r][j][1]) + (v[r][j][2] * v[r][j][2] + v[r][j][3] * v[r][j][3]);
        const float rstd0 = rsqrtf(wave_sum(s[0]) * (1.f / DM) + EPS), rstd1 = rsqrtf(wave_sum(s[1]) * (1.f / DM) + EPS);
#pragma unroll
        for (int j = 0; j < 4; ++j) { const int c0 = 4 * (F.lane + 64 * j);
            const f32x4 gv = *(const f32x4*)(g + c0), sh = *(const f32x4*)(mod + b * 6144 + c0), sc = *(const f32x4*)(mod + b * 6144 + 1024 + c0);
            const f32x4 gs = gv * (sc + 1.f);
#pragma unroll
            for (int r = 0; r < 2; ++r) { const f32x4 h = (v[r][j] * (r ? rstd1 : rstd0) * gs + sh) * SC_H;
                ((unsigned*)((unsigned char*)H + (size_t)(m0 + r) * DM) + F.lane)[64 * j] = pk4_fp8(h[0], h[1], h[2], h[3]); } }
    }
}


typedef short v4i16_t __attribute__((ext_vector_type(4)));
typedef float f32x16 __attribute__((ext_vector_type(16)));
__device__ __forceinline__ int crow(int r, int hi) { return (r & 3) + 8 * (r >> 2) + 4 * hi; }
constexpr int AT_STR = 144;
__device__ __forceinline__ void phase_attn(const Ctx& F, const Args& A) {
    LAS unsigned char* Kl = F.lds; LAS unsigned char* Vl = F.lds + 256 * AT_STR; LAS float* tab = (LAS float*)(F.lds + 2 * 256 * AT_STR);
    const bf16* PROJ = (const bf16*)(A.ws + WS_PROJ); bf16* MIX = (bf16*)(A.ws + WS_MIX);
    const float* sinks = A.in[7]; const float* relb = A.in[8];
    constexpr float L2E = 1.4426950408889634f;
    for (int i = F.tid; i < 8 * 192; i += 512) { const int h = i / 192, dd = i % 192 - 32; const int n = dd < 0 ? 0 : (dd > 127 ? 127 : dd); int bkt = n;
        if (n >= 16) { const int l = 16 + (int)(logf((float)n / 16.f) / logf(8.f) * 16.f); bkt = l < 31 ? l : 31; }
        tab[i] = relb[bkt * 8 + h] * L2E; }
    const int ql = F.lane & 31, hh = F.lane >> 5, wq = F.wave & 3, r0 = wq * 32;
    const int i16 = F.lane & 15, tq = i16 >> 2, tp = i16 & 3, blk = (F.lane >> 4) & 1;
    v4u kreg[4], vreg[4];
#define AT_LOAD_KV(uu) do { const int kvh_ = (uu) & 1, n_ = ((uu) >> 1) & 31, b_ = (uu) >> 6; _Pragma("unroll") for (int i = 0; i < 4; ++i) { const int id = F.tid + 512 * i, key = id >> 3, c = id & 7, pos = (n_ - 1) * 128 + key; \
        kreg[i] = (v4u){0u, 0u, 0u, 0u}; vreg[i] = (v4u){0u, 0u, 0u, 0u}; \
        if (pos >= 0) { const bf16* src = PROJ + (size_t)(b_ * SEQ + pos) * INC + kvh_ * 64 + c * 8; kreg[i] = *(const v4u*)(src + C_AK); vreg[i] = *(const v4u*)(src + C_AV); } } } while (0)
    if ((int)blockIdx.x < 512) AT_LOAD_KV((int)blockIdx.x);
    for (int u = blockIdx.x; u < 512; u += F.G) {
        const int kvh = u & 1, n = (u >> 1) & 31, b = u >> 6;
        LDS_BARRIER();
#pragma unroll
        for (int i = 0; i < 4; ++i) { const int id = F.tid + 512 * i, key = id >> 3, c = id & 7;
            *(LAS v4u*)(Kl + key * AT_STR + c * 16) = kreg[i]; *(LAS v4u*)(Vl + key * AT_STR + c * 16) = vreg[i]; }
        bf16x8 qf0[4], qf1[4];
        { const size_t tok = (size_t)(b * SEQ + n * 128 + r0 + ql);
          const bf16* q0 = PROJ + tok * INC + C_AQ + (kvh * 4 + (F.wave >> 2)) * 64 + 8 * hh; const bf16* q1 = q0 + 2 * 64;
#pragma unroll
          for (int s = 0; s < 4; ++s) { qf0[s] = *(const bf16x8*)(q0 + 16 * s); qf1[s] = *(const bf16x8*)(q1 + 16 * s); } }
        if (u + F.G < 512) AT_LOAD_KV(u + F.G);
        LDS_BARRIER();
#pragma unroll 1
        for (int p = 0; p < 2; ++p) {
            const int head = kvh * 4 + p * 2 + (F.wave >> 2);
            const size_t tok = (size_t)(b * SEQ + n * 128 + r0 + ql);
            bf16x8 qf[4];
#pragma unroll
            for (int s = 0; s < 4; ++s) qf[s] = p ? qf1[s] : qf0[s];
            f32x16 sacc[5];
            const f32x16 zero16 = {0.f, 0.f, 0.f, 0.f, 0.f, 0.f, 0.f, 0.f, 0.f, 0.f, 0.f, 0.f, 0.f, 0.f, 0.f, 0.f};
#pragma unroll
            for (int kt = 0; kt < 5; ++kt) {
                const LAS unsigned char* kb = Kl + ((wq + kt) * 32 + ql) * AT_STR + 16 * hh;
#pragma unroll
                for (int s = 0; s < 4; ++s) { const bf16x8 kf = *(const LAS bf16x8*)(kb + 32 * s); sacc[kt] = __builtin_amdgcn_mfma_f32_32x32x16_bf16(kf, qf[s], s == 0 ? zero16 : sacc[kt], 0, 0, 0); } }
            const LAS float* tabh = tab + head * 192 + (ql + 160 - 4 * hh);
            const float sk = sinks[head] * L2E;
            float mx = sk;
#pragma unroll
            for (int kt = 0; kt < 5; ++kt) {
                const bool tile_ok = (n > 0) || (wq + kt >= 4);
                if (tile_ok) {
#pragma unroll
                    for (int i = 0; i < 16; ++i) { const int ml = (i & 3) + 8 * (i >> 2) + 4 * hh;
                        float s = sacc[kt][i] * (0.125f * L2E) + tabh[-(32 * kt + 8 * (i >> 2) + (i & 3))];
                        if (kt == 0) s = (ml > ql) ? s : -1e30f;
                        if (kt == 4) s = (ml <= ql) ? s : -1e30f;
                        sacc[kt][i] = s; mx = fmaxf(mx, s); }
                } else {
#pragma unroll
                    for (int i = 0; i < 16; ++i) sacc[kt][i] = -1e30f;
                }
                __builtin_amdgcn_sched_barrier(0);
            }
            mx = fmaxf(mx, __shfl_xor(mx, 32));
            float sum = 0.f;
#pragma unroll
            for (int kt = 0; kt < 5; ++kt)
#pragma unroll
                for (int i = 0; i < 16; ++i) { const float pv = __builtin_amdgcn_exp2f(sacc[kt][i] - mx); sacc[kt][i] = pv; sum += pv; }
            sum += __shfl_xor(sum, 32);
            sum += __builtin_amdgcn_exp2f(sk - mx);
            f32x16 o[2];
#pragma unroll
            for (int kt = 0; kt < 5; ++kt)
#pragma unroll
                for (int s2 = 0; s2 < 2; ++s2) {
                    v4u pw; pw.x = cvtpk(sacc[kt][8 * s2], sacc[kt][8 * s2 + 1]); pw.y = cvtpk(sacc[kt][8 * s2 + 2], sacc[kt][8 * s2 + 3]);
                    pw.z = cvtpk(sacc[kt][8 * s2 + 4], sacc[kt][8 * s2 + 5]); pw.w = cvtpk(sacc[kt][8 * s2 + 6], sacc[kt][8 * s2 + 7]);
                    const bf16x8 pf = __builtin_bit_cast(bf16x8, pw);
                    const LAS unsigned char* vb = Vl + ((wq + kt) * 32 + 16 * s2 + 4 * hh + tq) * AT_STR + 32 * blk + 8 * tp;
#pragma unroll
                    for (int dt = 0; dt < 2; ++dt) {
                        const v4i16_t lo = __builtin_amdgcn_ds_read_tr16_b64_v4i16((LAS v4i16_t*)(vb + dt * 64));
                        const v4i16_t hi = __builtin_amdgcn_ds_read_tr16_b64_v4i16((LAS v4i16_t*)(vb + dt * 64 + 8 * AT_STR));
                        const bf16x8 vf = {lo[0], lo[1], lo[2], lo[3], hi[0], hi[1], hi[2], hi[3]};
                        o[dt] = __builtin_amdgcn_mfma_f32_32x32x16_bf16(vf, pf, (kt == 0 && s2 == 0) ? zero16 : o[dt], 0, 0, 0); } }
            const float inv = (OUTPROJ_FP8 ? SC_MIX : 1.f) / sum;
            bf16* orow = MIX + tok * DM + head * 64 + 4 * hh;
            if constexpr (OUTPROJ_FP8) { unsigned char* orow8 = (unsigned char*)MIX + tok * DM + head * 64 + 4 * hh;
#pragma unroll
                for (int dt = 0; dt < 2; ++dt)
#pragma unroll
                    for (int g = 0; g < 4; ++g) *(unsigned*)(orow8 + dt * 32 + 8 * g) = pk4_fp8(o[dt][4 * g] * inv, o[dt][4 * g + 1] * inv, o[dt][4 * g + 2] * inv, o[dt][4 * g + 3] * inv); }
            else
#pragma unroll
            for (int dt = 0; dt < 2; ++dt)
#pragma unroll
                for (int g = 0; g < 4; ++g) { v2u w; w.x = cvtpk(o[dt][4 * g] * inv, o[dt][4 * g + 1] * inv); w.y = cvtpk(o[dt][4 * g + 2] * inv, o[dt][4 * g + 3] * inv);
                    *(v2u*)(orow + dt * 32 + 8 * g) = w; }
        }
    }
#undef AT_LOAD_KV
    __syncthreads();
}


constexpr int HG_QSTR = 272, HG_TSTR = 80;
constexpr int HB_QP = 0, HB_QI = 8704, HB_KP = 17408, HB_KT = 26112, HB_VT = 36352, HB_D = 46592, HB_SIZE = 47104;
constexpr int HG_SEG = 512, HG_NCH = 16, HG_NSEG = SEQ / HG_SEG;
__device__ __forceinline__ int perm16(int k) { return 8 * ((k >> 2) & 1) + (k & 3) + 4 * (k >> 3); }

template <int PASS>
__device__ __forceinline__ void hg_produce(LAS unsigned char* buf, const unsigned (&rq)[8], const unsigned (&rk)[8], const unsigned (&rv)[8], int p, int lane, float (&cumD)[2]) {
    const int cpl = lane & 15, tg = lane >> 4; const bool first = tg < 2, odd = (tg & 1) != 0;
    const int ch0 = 32 * p + 2 * cpl, cpos = (ch0 & ~15) + perm16(ch0 & 15), hpos = 16 * (tg >> 1) + (odd ? 4 : 0);
    float lf[2][8], lbw[2][8], fs[2], bs[2], qis[2], kts[2];
#pragma unroll
    for (int ci = 0; ci < 2; ++ci) {
        lf[ci][0] = 1.f - (ci ? bfhi(rk[0]) : bflo(rk[0]));
#pragma unroll
        for (int i = 1; i < 8; ++i) lf[ci][i] = lf[ci][i - 1] * (1.f - (ci ? bfhi(rk[i]) : bflo(rk[i])));
        lbw[ci][7] = 1.f;
#pragma unroll
        for (int i = 6; i >= 0; --i) lbw[ci][i] = lbw[ci][i + 1] * (1.f - (ci ? bfhi(rk[i + 1]) : bflo(rk[i + 1])));
        const float Tg = lf[ci][7];
        float Tn, HTo;
        { auto rr = __builtin_amdgcn_permlane16_swap(__float_as_uint(Tg), __float_as_uint(Tg), false, false); Tn = odd ? __uint_as_float(rr[0]) : __uint_as_float(rr[1]); }
        const float HT = Tg * Tn;
        { auto rr = __builtin_amdgcn_permlane32_swap(__float_as_uint(HT), __float_as_uint(HT), false, false); HTo = first ? __uint_as_float(rr[1]) : __uint_as_float(rr[0]); }
        fs[ci] = odd ? Tn : 1.f; bs[ci] = odd ? 1.f : Tn; qis[ci] = first ? 1.f : HTo; kts[ci] = first ? HTo : 1.f;
        cumD[ci] *= HT * HTo;
        if (tg == 0) *(LAS float*)(buf + HB_D + (ch0 + ci) * 4) = HT * HTo;
    }
    unsigned ktp[2][4];
#pragma unroll
    for (int i = 0; i < 8; i += 2) {
        float ktv[2][2];
#pragma unroll
        for (int e = 0; e < 2; ++e) {
            float qpv[2], kpv[2], qiv[2];
#pragma unroll
            for (int ci = 0; ci < 2; ++ci) { const float k = ci ? bfhi(rk[i + e]) : bflo(rk[i + e]); const float fwd = lf[ci][i + e] * fs[ci], bwd = lbw[ci][i + e] * bs[ci];
                ktv[ci][e] = k * bwd * kts[ci];
                if (PASS == 2) { const float q = ci ? bfhi(rq[i + e]) : bflo(rq[i + e]); const float X = first ? bwd : fwd; const float inv = __builtin_amdgcn_rcpf(fmaxf(X, 1e-30f));
                    qpv[ci] = q * (first ? inv : X); kpv[ci] = k * (first ? X : inv); qiv[ci] = q * fwd * qis[ci]; } }
            if (PASS == 2) { const int off = (8 * tg + i + e) * HG_QSTR + cpos * 2;
                *(LAS unsigned*)(buf + HB_QP + off) = cvtpk(qpv[0], qpv[1]); *(LAS unsigned*)(buf + HB_KP + off) = cvtpk(kpv[0], kpv[1]); *(LAS unsigned*)(buf + HB_QI + off) = cvtpk(qiv[0], qiv[1]); }
        }
        ktp[0][i >> 1] = cvtpk(ktv[0][0], ktv[0][1]); ktp[1][i >> 1] = cvtpk(ktv[1][0], ktv[1][1]);
    }
#pragma unroll
    for (int ci = 0; ci < 2; ++ci) {
        *(LAS v2u*)(buf + HB_KT + (ch0 + ci) * HG_TSTR + hpos * 2) = (v2u){ktp[ci][0], ktp[ci][1]}; *(LAS v2u*)(buf + HB_KT + (ch0 + ci) * HG_TSTR + hpos * 2 + 16) = (v2u){ktp[ci][2], ktp[ci][3]};
        v2u x0, x1;
        if (ci == 0) { x0.x = (rv[0] & 0xffffu) | (rv[1] << 16); x0.y = (rv[2] & 0xffffu) | (rv[3] << 16); x1.x = (rv[4] & 0xffffu) | (rv[5] << 16); x1.y = (rv[6] & 0xffffu) | (rv[7] << 16); }
        else { x0.x = (rv[0] >> 16) | (rv[1] & 0xffff0000u); x0.y = (rv[2] >> 16) | (rv[3] & 0xffff0000u); x1.x = (rv[4] >> 16) | (rv[5] & 0xffff0000u); x1.y = (rv[6] >> 16) | (rv[7] & 0xffff0000u); }
        *(LAS v2u*)(buf + HB_VT + (ch0 + ci) * HG_TSTR + hpos * 2) = x0; *(LAS v2u*)(buf + HB_VT + (ch0 + ci) * HG_TSTR + hpos * 2 + 16) = x1;
    }
}
__device__ __forceinline__ unsigned gld32(const void* p) { unsigned r; asm volatile("global_load_dword %0, %1, off" : "=v"(r) : "v"(p)); return r; }
__device__ __forceinline__ v4u gld128(const void* p) { v4u r; asm volatile("global_load_dwordx4 %0, %1, off" : "=v"(r) : "v"(p)); return r; }
#define HG_R8(a) "+v"(a[0]), "+v"(a[1]), "+v"(a[2]), "+v"(a[3]), "+v"(a[4]), "+v"(a[5]), "+v"(a[6]), "+v"(a[7])
template <int PASS>
__device__ __forceinline__ void hg_wait_set(unsigned (&rq)[8], unsigned (&rk)[8], unsigned (&rv)[8]) {
    if (PASS == 2) asm volatile("s_waitcnt vmcnt(24)" : HG_R8(rq), HG_R8(rk), HG_R8(rv));
    else asm volatile("s_waitcnt vmcnt(16)" : HG_R8(rk), HG_R8(rv));
}
template <int PASS>
__device__ __forceinline__ void hg_drain_set(unsigned (&rq)[8], unsigned (&rk)[8], unsigned (&rv)[8]) {
    if (PASS == 2) asm volatile("s_waitcnt vmcnt(0)" : HG_R8(rq), HG_R8(rk), HG_R8(rv));
    else asm volatile("s_waitcnt vmcnt(0)" : HG_R8(rk), HG_R8(rv));
}
template <int PASS>
__device__ __forceinline__ void hg_load(unsigned (&rq)[8], unsigned (&rk)[8], unsigned (&rv)[8], const bf16* prow  ) {
#pragma unroll
    for (int i = 0; i < 8; ++i) { const bf16* r = prow + (size_t)i * INC; if (PASS == 2) rq[i] = gld32(r + C_HQ); rk[i] = gld32(r + C_HF); rv[i] = gld32(r + C_HI); }
}
template <int PASS>
__device__ __forceinline__ void hg_consume(const LAS unsigned char* buf, f32x16 (&S)[4], f32x16& o, int w, int lane) {
    const int ql = lane & 31, hh = lane >> 5;
    const LAS unsigned char* qrow = buf + ql * HG_QSTR + 16 * hh;
    const LAS unsigned char* vrow = buf + HB_VT + (32 * w + ql) * HG_TSTR + 16 * hh;
    const bf16x8 vt0 = *(const LAS bf16x8*)(vrow), vt1 = *(const LAS bf16x8*)(vrow + 32);
    if (PASS == 2) {
        f32x16 at; const f32x16 zero16 = {0.f, 0.f, 0.f, 0.f, 0.f, 0.f, 0.f, 0.f, 0.f, 0.f, 0.f, 0.f, 0.f, 0.f, 0.f, 0.f};
#pragma unroll
        for (int kap = 0; kap < 8; ++kap) { const bf16x8 kf = *(const LAS bf16x8*)(qrow + HB_KP + 32 * kap), qf = *(const LAS bf16x8*)(qrow + HB_QP + 32 * kap);
            at = __builtin_amdgcn_mfma_f32_32x32x16_bf16(kf, qf, kap == 0 ? zero16 : at, 0, 0, 0); }
#pragma unroll
        for (int tile = 0; tile < 4; ++tile)
#pragma unroll
            for (int k2 = 0; k2 < 2; ++k2) { v4u sw; sw.x = cvtpk(S[tile][8 * k2], S[tile][8 * k2 + 1]); sw.y = cvtpk(S[tile][8 * k2 + 2], S[tile][8 * k2 + 3]);
                sw.z = cvtpk(S[tile][8 * k2 + 4], S[tile][8 * k2 + 5]); sw.w = cvtpk(S[tile][8 * k2 + 6], S[tile][8 * k2 + 7]);
                const bf16x8 qf = *(const LAS bf16x8*)(qrow + HB_QI + 32 * (2 * tile + k2));
                o = __builtin_amdgcn_mfma_f32_32x32x16_bf16(__builtin_bit_cast(bf16x8, sw), qf, (tile == 0 && k2 == 0) ? zero16 : o, 0, 0, 0); }
        const int lim = ql - 4 * hh;
#pragma unroll
        for (int i = 0; i < 16; ++i) at[i] = (((i & 3) + 8 * (i >> 2)) <= lim) ? at[i] : 0.f;
        v4u p0, p1; p0.x = cvtpk(at[0], at[1]); p0.y = cvtpk(at[2], at[3]); p0.z = cvtpk(at[4], at[5]); p0.w = cvtpk(at[6], at[7]);
        p1.x = cvtpk(at[8], at[9]); p1.y = cvtpk(at[10], at[11]); p1.z = cvtpk(at[12], at[13]); p1.w = cvtpk(at[14], at[15]);
        o = __builtin_amdgcn_mfma_f32_32x32x16_bf16(vt0, __builtin_bit_cast(bf16x8, p0), o, 0, 0, 0);
        o = __builtin_amdgcn_mfma_f32_32x32x16_bf16(vt1, __builtin_bit_cast(bf16x8, p1), o, 0, 0, 0);
    }
#pragma unroll
    for (int tile = 0; tile < 4; ++tile) {
#pragma unroll
        for (int g = 0; g < 4; ++g) { const f32x4 dv = *(const LAS f32x4*)(buf + HB_D + (32 * tile + 8 * g + 4 * hh) * 4);
            S[tile][4 * g] *= dv[0]; S[tile][4 * g + 1] *= dv[1]; S[tile][4 * g + 2] *= dv[2]; S[tile][4 * g + 3] *= dv[3]; }
        const LAS unsigned char* krow = buf + HB_KT + (32 * tile + ql) * HG_TSTR + 16 * hh;
        const bf16x8 k0 = *(const LAS bf16x8*)(krow), k1 = *(const LAS bf16x8*)(krow + 32);
        S[tile] = __builtin_amdgcn_mfma_f32_32x32x16_bf16(k0, vt0, S[tile], 0, 0, 0);
        S[tile] = __builtin_amdgcn_mfma_f32_32x32x16_bf16(k1, vt1, S[tile], 0, 0, 0);
    }
}
constexpr int HG_OSTR = 528, HG_OB = 2 * HB_SIZE, HG_OBSZ = 32 * HG_OSTR, HG_NW = HG_OB + 2 * HG_OBSZ;
__device__ __forceinline__ void hg_finish(const LAS unsigned char* ob, const v4u g0, const v4u g1  , const LAS float* nwl  , bf16* mrow  , int p, int lane) {
    const int tl = lane >> 3, vg = lane & 7;
    const LAS unsigned char* orow = ob + (8 * p + tl) * HG_OSTR + vg * 64;
    f32x4 ov[4]; float ss = 0.f;
#pragma unroll
    for (int j = 0; j < 4; ++j) { ov[j] = *(const LAS f32x4*)(orow + 16 * j); ss += (ov[j][0] * ov[j][0] + ov[j][1] * ov[j][1]) + (ov[j][2] * ov[j][2] + ov[j][3] * ov[j][3]); }
    ss += __shfl_xor(ss, 1); ss += __shfl_xor(ss, 2); ss += __shfl_xor(ss, 4);
    const float rstd = rsqrtf(ss * (1.f / 128.f) + EPS);
    unsigned r[8];
#pragma unroll
    for (int j = 0; j < 4; ++j) { const f32x4 wv = *(const LAS f32x4*)(nwl + 4 * j); const unsigned ga = (j < 2) ? g0[2 * j] : g1[2 * j - 4], gb = (j < 2) ? g0[2 * j + 1] : g1[2 * j - 3];
        r[2 * j] = cvtpk(ov[j][0] * rstd * wv[0] * bflo(ga), ov[j][1] * rstd * wv[1] * bfhi(ga)); r[2 * j + 1] = cvtpk(ov[j][2] * rstd * wv[2] * bflo(gb), ov[j][3] * rstd * wv[3] * bfhi(gb)); }
    if constexpr (OUTPROJ_FP8) {
        unsigned q[4]; const float rs = rstd * SC_MIX;
#pragma unroll
        for (int j = 0; j < 4; ++j) { const f32x4 wv = *(const LAS f32x4*)(nwl + 4 * j); const unsigned ga = (j < 2) ? g0[2 * j] : g1[2 * j - 4], gb = (j < 2) ? g0[2 * j + 1] : g1[2 * j - 3];
            q[j] = pk4_fp8(ov[j][0] * rs * wv[0] * bflo(ga), ov[j][1] * rs * wv[1] * bfhi(ga), ov[j][2] * rs * wv[2] * bflo(gb), ov[j][3] * rs * wv[3] * bfhi(gb)); }
        *(v4u*)((unsigned char*)mrow) = (v4u){q[0], q[1], q[2], q[3]}; return; }
    *(v4u*)(mrow) = (v4u){r[0], r[1], r[2], r[3]}; *(v4u*)(mrow + 8) = (v4u){r[4], r[5], r[6], r[7]};
}
template <int PASS>
__device__ __forceinline__ void phase_hgrn(const Ctx& F, const Args& A) {
    const bf16* PROJ = (const bf16*)(A.ws + WS_PROJ); bf16* MIX = (bf16*)(A.ws + WS_MIX); float* TSEG_ = (float*)(A.ws + WS_TSEG); float* DSEG = (float*)(A.ws + WS_DSEG); const float* nw_ = A.in[10];
    LAS unsigned char* buf0 = F.lds; LAS unsigned char* buf1 = F.lds + HB_SIZE; LAS unsigned char* ob0 = F.lds + HG_OB; LAS unsigned char* ob1 = ob0 + HG_OBSZ;
    const bool producer = F.wave >= 4; const int w = F.wave & 3, ql = F.lane & 31, hh = F.lane >> 5;
    for (int uid = F.vcu; uid < BATCH * 4 * HG_NSEG; uid += F.G) {
        const int seg = uid % HG_NSEG, h = (uid / HG_NSEG) & 3, b = uid / (HG_NSEG * 4);
        const size_t tok0 = (size_t)b * SEQ + (size_t)seg * HG_SEG;
        const GAS float* nw = (const GAS float*)nw_; GAS float* TSEG = (GAS float*)TSEG_; asm volatile("" : "+s"(nw), "+s"(TSEG));
        __syncthreads();
        if (PASS == 2) { LAS float* dl = (LAS float*)(F.lds + HG_OB); for (int i = F.tid; i < seg * 128; i += 512) dl[i] = DSEG[(size_t)(uid - seg) * 128 + i]; if (F.tid < 128) ((LAS float*)(F.lds + HG_NW))[F.tid] = nw[F.tid]; }
        __syncthreads();
        if (producer) {
            unsigned rq0[8], rk0[8], rv0[8], rq1[8], rk1[8], rv1[8]; float cumD[2] = {1.f, 1.f};
#pragma unroll
            for (int i = 0; i < 8; ++i) { rq0[i] = 0u; rq1[i] = 0u; }
            const bf16* pbase = PROJ + (tok0 + 8 * (F.lane >> 4)) * INC + h * 128 + 32 * w + 2 * (F.lane & 15);
            hg_load<PASS>(rq0, rk0, rv0, pbase); hg_load<PASS>(rq1, rk1, rv1, pbase + (size_t)32 * INC);
            const size_t ftok = tok0 + 8 * w + (F.lane >> 3); const int fcol = h * 128 + 16 * (F.lane & 7);
            const LAS float* nwv = (const LAS float*)(F.lds + HG_NW) + 16 * (F.lane & 7);
            const bf16* gbase = PROJ + ftok * INC + C_HG + fcol;
            v4u ga0 = {0u, 0u, 0u, 0u}, ga1 = ga0, gb0 = ga0, gb1 = ga0;
            if (PASS == 2) { ga0 = gld128(gbase); ga1 = gld128(gbase + 8); }
            LDS_BARRIER();
#define HG_CL(c) ((c) < 0 ? 0 : ((c) > HG_NCH - 1 ? HG_NCH - 1 : (c)))
#pragma unroll 1
            for (int sp = -1; sp < HG_NCH; sp += 2) {
                if (PASS == 2) { const bf16* gp = gbase + (size_t)(32 * HG_CL(sp)) * INC; gb0 = gld128(gp); gb1 = gld128(gp + 8); }
                hg_wait_set<PASS>(rq0, rk0, rv0);
                if (sp + 1 < HG_NCH) hg_produce<PASS>(buf0, rq0, rk0, rv0, w, F.lane, cumD);
                hg_load<PASS>(rq0, rk0, rv0, pbase + (size_t)(32 * HG_CL(sp + 3)) * INC);
                if (PASS == 2) { asm volatile("s_waitcnt vmcnt(24)" : "+v"(ga0), "+v"(ga1));
                    if (sp >= 1) hg_finish(ob0, ga0, ga1, nwv, OUTPROJ_FP8 ? (bf16*)((unsigned char*)MIX + (ftok + 32 * (sp - 1)) * DM + 512 + fcol) : MIX + (ftok + 32 * (sp - 1)) * DM + 512 + fcol, w, F.lane); }
                LDS_BARRIER();
                if (PASS == 2) { const bf16* gp = gbase + (size_t)(32 * HG_CL(sp + 1)) * INC; ga0 = gld128(gp); ga1 = gld128(gp + 8); }
                hg_wait_set<PASS>(rq1, rk1, rv1);
                if (sp + 2 < HG_NCH) hg_produce<PASS>(buf1, rq1, rk1, rv1, w, F.lane, cumD);
                hg_load<PASS>(rq1, rk1, rv1, pbase + (size_t)(32 * HG_CL(sp + 4)) * INC);
                if (PASS == 2) { asm volatile("s_waitcnt vmcnt(24)" : "+v"(gb0), "+v"(gb1));
                    if (sp >= 0) hg_finish(ob1, gb0, gb1, nwv, OUTPROJ_FP8 ? (bf16*)((unsigned char*)MIX + (ftok + 32 * sp) * DM + 512 + fcol) : MIX + (ftok + 32 * sp) * DM + 512 + fcol, w, F.lane); }
                LDS_BARRIER();
            }
#undef HG_CL
            hg_drain_set<PASS>(rq0, rk0, rv0); hg_drain_set<PASS>(rq1, rk1, rv1);
            if (PASS == 2) asm volatile("" : "+v"(ga0), "+v"(ga1), "+v"(gb0), "+v"(gb1));
            if (PASS == 1 && (F.lane >> 4) == 0) { DSEG[(size_t)uid * 128 + 32 * w + 2 * (F.lane & 15)] = cumD[0]; DSEG[(size_t)uid * 128 + 32 * w + 2 * (F.lane & 15) + 1] = cumD[1]; }
        } else {
            f32x16 S[4];
#pragma unroll
            for (int t = 0; t < 4; ++t)
#pragma unroll
                for (int i = 0; i < 16; ++i) S[t][i] = 0.f;
            if (PASS == 2 && seg > 0) {
                const LAS float* dl = (const LAS float*)(F.lds + HG_OB);
                const GAS float* Tl = TSEG + (size_t)(uid - seg) * 16384 + (size_t)(w * 64 + F.lane) * 64;
#pragma unroll
                for (int hf = 0; hf < 2; ++hf) {
                    f32x4 Tn[8];
#pragma unroll
                    for (int x = 0; x < 8; ++x) Tn[x] = *(const GAS f32x4*)(Tl + 32 * hf + 4 * x);
                    for (int j = 0; j < seg; ++j) {
                        f32x4 Tc[8];
#pragma unroll
                        for (int x = 0; x < 8; ++x) Tc[x] = Tn[x];
                        if (j + 1 < seg) {
#pragma unroll
                            for (int x = 0; x < 8; ++x) Tn[x] = *(const GAS f32x4*)(Tl + (size_t)(j + 1) * 16384 + 32 * hf + 4 * x); }
#pragma unroll
                        for (int tt = 0; tt < 2; ++tt)
#pragma unroll
                            for (int g = 0; g < 4; ++g) { const int t = 2 * hf + tt; const f32x4 dv = *(const LAS f32x4*)(dl + j * 128 + 32 * t + 8 * g + 4 * hh);
#pragma unroll
                                for (int e = 0; e < 4; ++e) S[t][4 * g + e] = dv[e] * S[t][4 * g + e] + Tc[4 * tt + g][e]; }
                    }
                }
            }
            LDS_BARRIER();
            const int ooff = ql * HG_OSTR + (32 * w + 4 * hh) * 4;
#pragma unroll 1
            for (int sp = -1; sp < HG_NCH; sp += 2) {
                if (sp >= 0) { f32x16 o; hg_consume<PASS>(buf1, S, o, w, F.lane);
                    if (PASS == 2) {
#pragma unroll
                        for (int g = 0; g < 4; ++g) *(LAS f32x4*)(ob1 + ooff + 32 * g) = (f32x4){o[4 * g], o[4 * g + 1], o[4 * g + 2], o[4 * g + 3]}; } }
                LDS_BARRIER();
                if (sp + 1 < HG_NCH) { f32x16 o; hg_consume<PASS>(buf0, S, o, w, F.lane);
                    if (PASS == 2) {
#pragma unroll
                        for (int g = 0; g < 4; ++g) *(LAS f32x4*)(ob0 + ooff + 32 * g) = (f32x4){o[4 * g], o[4 * g + 1], o[4 * g + 2], o[4 * g + 3]}; } }
                LDS_BARRIER();
            }
            if (PASS == 1) { GAS float* Tl = TSEG + (size_t)uid * 16384 + (size_t)(w * 64 + F.lane) * 64;
#pragma unroll
                for (int t = 0; t < 4; ++t)
#pragma unroll
                    for (int g = 0; g < 4; ++g) *(GAS f32x4*)(Tl + 16 * t + 4 * g) = (f32x4){S[t][4 * g], S[t][4 * g + 1], S[t][4 * g + 2], S[t][4 * g + 3]}; }
        }
    }
    __syncthreads();
}

__device__ __forceinline__ void phase_route(const Ctx& F, const Args& A) {
    const bf16* XM = (const bf16*)(A.ws + WS_XM); const float* mod = (const float*)(A.ws + WS_MOD); const float* gf = A.in[13]; const float* SSQ = (const float*)(A.ws + WS_SSQP); const float* SHW = (const float*)(A.ws + WS_SHW);
    bf16* H = (bf16*)(A.ws + WS_H); const v4u* wrf = (const v4u*)(A.ws + WS_WRF);
    int* TKE = (int*)(A.ws + WS_TKE); float* TKW = (float*)(A.ws + WS_TKW); int* LIST = (int*)(A.ws + WS_LIST); int* RNK = (int*)(A.ws + WS_RNK); unsigned* cnt = (unsigned*)(A.ws + WS_CTL) + CW_CNT;
    LAS int* hist = (LAS int*)(F.lds + L_HIST); LAS int* base = (LAS int*)(F.lds + L_BASE);
    LAS v4u* wl = (LAS v4u*)F.lds; LAS float* G2 = (LAS float*)(F.lds + 131072); LAS float* SH = G2 + 1024;
    const int tr = F.lane & 15, q = F.lane >> 4;
    int cur_b = -1;
    for (int item = F.vcu; item < NTOK / 128; item += F.G) {
        const int tok0 = item * 128 + F.wave * 16, b = tok0 >> 12;
        __syncthreads();
        if (cur_b < 0) {
#pragma unroll 1
            for (int hb = 0; hb < 2; ++hb) { v4u t8[8];
#pragma unroll
                for (int i = 0; i < 8; ++i) t8[i] = wrf[F.tid + 512 * (8 * hb + i)];
#pragma unroll
                for (int i = 0; i < 8; ++i) wl[F.tid + 512 * (8 * hb + i)] = t8[i]; } }
        if (b != cur_b) { for (int k = F.tid; k < 1024; k += 512) { G2[k] = gf[k] * (1.f + mod[b * 6144 + 4096 + k]); SH[k] = mod[b * 6144 + 3072 + k]; } cur_b = b; }
        if (F.tid < 32) hist[F.tid] = 0;
        __syncthreads();
#define RT_CS(s) (MOE1_FP6 ? 128 * ((s) >> 2) + 8 * ((s) & 3) : 32 * (s))
        const int kq = MOE1_FP6 ? 32 * q : 8 * q;
        const bf16* xrow = XM + (size_t)(tok0 + tr) * DM + kq;
        constexpr int RT_PF = 8;
        v4u xa[RT_PF];
#pragma unroll
        for (int s = 0; s < RT_PF; ++s) xa[s] = *(const v4u*)(xrow + RT_CS(s));
        f32x16_ h6lo, h6hi;
        float rstd;
        { const f32x4 p4 = *(const f32x4*)(SSQ + (size_t)(tok0 + tr) * 16 + 4 * q); float ss = (p4[0] + p4[1]) + (p4[2] + p4[3]); ss += __shfl_xor(ss, 16); ss += __shfl_xor(ss, 32); rstd = rsqrtf(ss * (1.f / DM) + EPS); }
        f32x4 acc0 = {0.f, 0.f, 0.f, 0.f}, acc1 = {0.f, 0.f, 0.f, 0.f};
        unsigned char* hrow = (unsigned char*)H + (size_t)(tok0 + tr) * DM + (MOE1_FP6 ? 16 * q : 8 * q);
#pragma unroll 1
        for (int so = 0; so < 4; ++so)
#pragma unroll
        for (int si = 0; si < 8; ++si) { const int s = 8 * so + si, cs = 256 * so + RT_CS(si), k0 = cs + kq;
            float hv[8];
#pragma unroll
            for (int p = 0; p < 2; ++p) { const unsigned xw0 = p ? xa[si].z : xa[si].x, xw1 = p ? xa[si].w : xa[si].y; const f32x4 xv = {bflo(xw0), bfhi(xw0), bflo(xw1), bfhi(xw1)}, gv = *(const LAS f32x4*)(G2 + k0 + 4 * p), sh = *(const LAS f32x4*)(SH + k0 + 4 * p);
                const f32x4 h = xv * rstd * gv + sh; hv[4 * p] = h[0]; hv[4 * p + 1] = h[1]; hv[4 * p + 2] = h[2]; hv[4 * p + 3] = h[3]; }
            if constexpr (MOE1_FP6) {
                if ((si & 3) == 3 && so < 3) {
#pragma unroll
                    for (int t = 0; t < 4; ++t) xa[si - 3 + t] = *(const v4u*)(xrow + 256 * so + RT_CS(si - 3 + t) + 256); } }
            else if (so < 3) xa[si] = *(const v4u*)(xrow + cs + 256);
            v4u ph, pl; ph.x = cvtpk(hv[0], hv[1]); ph.y = cvtpk(hv[2], hv[3]); ph.z = cvtpk(hv[4], hv[5]); ph.w = cvtpk(hv[6], hv[7]);
            pl.x = cvtpk(hv[0] - bflo(ph.x), hv[1] - bfhi(ph.x)); pl.y = cvtpk(hv[2] - bflo(ph.y), hv[3] - bfhi(ph.y));
            pl.z = cvtpk(hv[4] - bflo(ph.z), hv[5] - bfhi(ph.z)); pl.w = cvtpk(hv[6] - bflo(ph.w), hv[7] - bfhi(ph.w));
            if constexpr (MOE1_FP6) {
#pragma unroll
                for (int j = 0; j < 8; ++j) { if ((si & 3) < 2) h6lo[8 * (si & 3) + j] = hv[j] * SC_H6; else h6hi[8 * ((si & 3) - 2) + j] = hv[j] * SC_H6; }
                if ((si & 3) == 3) { const v6u o = pk32_fp6(h6lo, h6hi); unsigned char* d = hrow + 256 * so + 128 * (si >> 2);
                    *(v4u*)d = (v4u){o[0], o[1], o[2], o[3]}; *(v2u*)(d + 64) = (v2u){o[4], o[5]}; } }
            else { v2u h8; h8.x = pk4_fp8(hv[0] * SC_H, hv[1] * SC_H, hv[2] * SC_H, hv[3] * SC_H); h8.y = pk4_fp8(hv[4] * SC_H, hv[5] * SC_H, hv[6] * SC_H, hv[7] * SC_H); *(v2u*)(hrow + 256 * so + 32 * si) = h8; }
            const bf16x8 ah = __builtin_bit_cast(bf16x8, ph), al = __builtin_bit_cast(bf16x8, pl);
            const bf16x8 bh0 = __builtin_bit_cast(bf16x8, wl[((s * 2 + 0) * 2 + 0) * 64 + F.lane]), bl0 = __builtin_bit_cast(bf16x8, wl[((s * 2 + 0) * 2 + 1) * 64 + F.lane]);
            const bf16x8 bh1 = __builtin_bit_cast(bf16x8, wl[((s * 2 + 1) * 2 + 0) * 64 + F.lane]), bl1 = __builtin_bit_cast(bf16x8, wl[((s * 2 + 1) * 2 + 1) * 64 + F.lane]);
            acc0 = __builtin_amdgcn_mfma_f32_16x16x32_bf16(ah, bh0, acc0, 0, 0, 0); acc0 = __builtin_amdgcn_mfma_f32_16x16x32_bf16(ah, bl0, acc0, 0, 0, 0); acc0 = __builtin_amdgcn_mfma_f32_16x16x32_bf16(al, bh0, acc0, 0, 0, 0);
            acc1 = __builtin_amdgcn_mfma_f32_16x16x32_bf16(ah, bh1, acc1, 0, 0, 0); acc1 = __builtin_amdgcn_mfma_f32_16x16x32_bf16(ah, bl1, acc1, 0, 0, 0); acc1 = __builtin_amdgcn_mfma_f32_16x16x32_bf16(al, bh1, acc1, 0, 0, 0);
        }
        const float br0 = A.in[15][tr], br1 = A.in[15][16 + tr];
        float tv[4][4]; int ti[4][4];
#pragma unroll
        for (int j = 0; j < 4; ++j) { float a = acc0[j] + br0, c = acc1[j] + br1;
#pragma unroll
            for (int r = 0; r < 4; ++r) { float bv = a >= c ? a : c; int bi = a >= c ? tr : tr + 16;
#pragma unroll
                for (int off = 1; off < 16; off <<= 1) { const float ov = __shfl_xor(bv, off); const int oi = __shfl_xor(bi, off); const bool take = (ov > bv) || (ov == bv && oi < bi); bv = take ? ov : bv; bi = take ? oi : bi; }
                tv[j][r] = bv; ti[j][r] = bi; if (bi == tr) a = -INFINITY; if (bi == tr + 16) c = -INFINITY; } }
        const int jj = (F.lane >> 2) & 3, kk = F.lane & 3;
        int e = 0; float w = 0.f;
#pragma unroll
        for (int j = 0; j < 4; ++j) { const float e1 = __expf(tv[j][1] - tv[j][0]), e2 = __expf(tv[j][2] - tv[j][0]), e3 = __expf(tv[j][3] - tv[j][0]); const float inv = 1.f / (1.f + e1 + e2 + e3);
            const float wk[4] = {inv, e1 * inv, e2 * inv, e3 * inv};
#pragma unroll
            for (int r = 0; r < 4; ++r) if (jj == j && kk == r) { e = ti[j][r]; w = wk[r]; } }
        const int slot = (tok0 + 4 * q + jj) * 4 + kk;
        TKE[slot] = e; TKW[slot] = w;
        const int rank = __hip_atomic_fetch_add(hist + e, 1, __ATOMIC_RELAXED, __HIP_MEMORY_SCOPE_WORKGROUP);
        __syncthreads();
        if (F.tid < 32) base[F.tid] = (int)__hip_atomic_fetch_add(cnt + 16 * F.tid, (unsigned)hist[F.tid], RLX_AGENT);
        __syncthreads();
        LIST[e * LIST_CAP + base[e] + rank] = slot; RNK[slot] = base[e] + rank;
    }
    __syncthreads();
}

__device__ __forceinline__ void phase_final(const Ctx& F, const Args& A) {
    const bf16* XM = (const bf16*)(A.ws + WS_XM); const float* mod = (const float*)(A.ws + WS_MOD); const unsigned char* Y = A.ws + WS_Y;
    const float* TKW = (const float*)(A.ws + WS_TKW); const float* gfin = A.in[20]; float* out = A.out;
    const int* TKE = (const int*)(A.ws + WS_TKE); const int* RNK = (const int*)(A.ws + WS_RNK); const LAS int* tb = (const LAS int*)(F.lds + L_TB);
    const int gw = F.vcu * 8 + F.wave, NGW = F.G * 8, c0 = 16 * F.lane;
    LAS unsigned char* img = F.lds + F.wave * 10240;
    const int own = F.lane * 80, coal = (F.lane >> 2) * 80 + (F.lane & 3) * 16;
    const int coal2 = (F.lane >> 1) * 80 + (F.lane & 1) * 16;
    for (int m0 = 2 * gw; m0 < NTOK; m0 += 2 * NGW) {
        const int b = m0 >> 12;
        v4u y[2][4]; f32x4 xv[2][4]; f32x4 wk[2]; v4u xb[2][2];
#pragma unroll
        for (int r = 0; r < 2; ++r) { const size_t m = (size_t)(m0 + r); wk[r] = *(const f32x4*)(TKW + m * 4);
#pragma unroll
            for (int k = 0; k < 4; ++k) { const int e = TKE[m * 4 + k], rk = RNK[m * 4 + k]; y[r][k] = *(const v4u*)(Y + (size_t)(tb[e] * 256 + rk) * DM + c0); }
#pragma unroll
            for (int j = 0; j < 2; ++j) xb[r][j] = *(const v4u*)(XM + m * DM + 8 * (F.lane + 64 * j)); }
        f32x4 gt[4], gf[4];
#pragma unroll
        for (int j = 0; j < 4; ++j) { gt[j] = *(const f32x4*)(mod + b * 6144 + 5120 + c0 + 4 * j) * (1.f / SC_Y); gf[j] = *(const f32x4*)(gfin + c0 + 4 * j); }
#pragma unroll
        for (int r = 0; r < 2; ++r)
#pragma unroll
            for (int j = 0; j < 2; ++j) *(LAS v4u*)(img + r * 5120 + coal2 + 2560 * j) = xb[r][j];
        asm volatile("s_waitcnt lgkmcnt(0)" ::: "memory");
#pragma unroll
        for (int r = 0; r < 2; ++r)
#pragma unroll
            for (int j = 0; j < 2; ++j) { const v4u t = *(const LAS v4u*)(img + r * 5120 + own + 16 * j);
                xv[r][2 * j] = (f32x4){bflo(t.x), bfhi(t.x), bflo(t.y), bfhi(t.y)}; xv[r][2 * j + 1] = (f32x4){bflo(t.z), bfhi(t.z), bflo(t.w), bfhi(t.w)}; }
        float ss[2] = {0.f, 0.f};
#pragma unroll
        for (int r = 0; r < 2; ++r)
#pragma unroll
            for (int j = 0; j < 4; ++j) { f32x4 moe = {0.f, 0.f, 0.f, 0.f};
#pragma unroll
                for (int k = 0; k < 4; ++k) { const int w = (int)y[r][k][j]; const f32x2 lo = __builtin_amdgcn_cvt_pk_f32_fp8(w, false), hi = __builtin_amdgcn_cvt_pk_f32_fp8(w, true);
                    moe += (f32x4){lo.x, lo.y, hi.x, hi.y} * wk[r][k]; }
                xv[r][j] = xv[r][j] + gt[j] * moe; ss[r] += (xv[r][j][0] * xv[r][j][0] + xv[r][j][1] * xv[r][j][1]) + (xv[r][j][2] * xv[r][j][2] + xv[r][j][3] * xv[r][j][3]); }
        const float rs0 = rsqrtf(wave_sum(ss[0]) * (1.f / DM) + EPS), rs1 = rsqrtf(wave_sum(ss[1]) * (1.f / DM) + EPS);
        asm volatile("s_waitcnt lgkmcnt(0)" ::: "memory");
#pragma unroll
        for (int r = 0; r < 2; ++r)
#pragma unroll
            for (int j = 0; j < 4; ++j) *(LAS f32x4*)(img + r * 5120 + own + 16 * j) = xv[r][j] * (r ? rs1 : rs0) * gf[j];
        asm volatile("s_waitcnt lgkmcnt(0)" ::: "memory");
#pragma unroll
        for (int r = 0; r < 2; ++r)
#pragma unroll
            for (int j = 0; j < 4; ++j) *(f32x4*)(out + (size_t)(m0 + r) * DM + 4 * (F.lane + 64 * j)) = *(const LAS f32x4*)(img + r * 5120 + coal + 1280 * j);
        asm volatile("s_waitcnt lgkmcnt(0)" ::: "memory");
    }
}

constexpr int N_PHASES = 10;
__global__ void __launch_bounds__(512, 2) hymba_fwd(Args args) {
    extern __shared__ __attribute__((aligned(16))) unsigned char lds_raw[];
    Ctx F; F.lds = (LAS unsigned char*)lds_raw; F.tid = threadIdx.x; F.lane = F.tid & 63; F.wave = __builtin_amdgcn_readfirstlane(F.tid >> 6);
    F.G = gridDim.x; { const int bx = blockIdx.x; F.vcu = (F.G % 8 == 0) ? (bx % 8) * (F.G / 8) + bx / 8 : bx; }
    unsigned char* ws = args.ws; unsigned* ctl = (unsigned*)(ws + WS_CTL);
    for (int u = F.tid; u < 1024; u += 512) ((LAS unsigned*)(F.lds + LDSCTL_OFF))[u] = 0u;
    __syncthreads();
    XcdBarrier bar; bar.bar = ctl + CW_BAR; bar.x = 0; bar.st = nullptr;
    if (!MK_PER_PHASE) bar = xcd_barrier_post(ctl + CW_BAR, (volatile LAS unsigned*)(F.lds + L_BARW));
    const int lo = args.ph_lo, hi = args.ph_hi;
#define IN(k) (lo <= (k) && (k) < hi)
#define SEAM(k) do { if (IN(k) && IN((k) + 1)) xcd_barrier(bar); } while (0)

    if (IN(0)) { phase_prologue(F, args); } SEAM(0);
    if (IN(1)) { phase_norm1(F, args); } SEAM(1);
    if (IN(2)) {
        pg8::Gemm g{(const bf16*)(ws + WS_H), (const bf16*)(ws + WS_WIN), NTOK, INC, DM / 2, 0, nullptr}; pg8::StaticOrder S; S.init(NTOK, INC, F.G, (int)blockIdx.x);
        pg8::EpiProj E{(bf16*)(ws + WS_PROJ), args.in[6], args.in[9], 1.f / (SC_H * SC_W)};
        pg8::gemm_phase<pg8::EpiProj, pg8::StaticOrder, true, false, true>(F.lds, g, S, E);
        phase_wd_tail(F, args);
    } SEAM(2);
    if (IN(3)) { phase_attn(F, args); phase_hgrn<1>(F, args); } SEAM(3);
    if (IN(4)) { phase_hgrn<2>(F, args); } SEAM(4);
    if (IN(5)) {
        pg8::Gemm g{(const bf16*)(ws + WS_MIX), (const bf16*)(ws + WS_WOUT), NTOK, DM, OUTPROJ_FP8 ? DM / 2 : DM, 0, nullptr}; pg8::StaticOrder S; S.init(NTOK, DM, F.G, (int)blockIdx.x);
        pg8::EpiRes E{(bf16*)(ws + WS_XM), args.in[0], args.in[12], (const float*)(ws + WS_MOD), (float*)(ws + WS_SSQP), OUTPROJ_FP8 ? 1.f / (SC_MIX * SC_WO) : 1.f};
        pg8::gemm_phase<pg8::EpiRes, pg8::StaticOrder, true, false, OUTPROJ_FP8>(F.lds, g, S, E);
    } SEAM(5);
    if (IN(6)) { phase_route(F, args); } SEAM(6);
    if (IN(7) || IN(8) || IN(9)) {
        LAS int* tb = (LAS int*)(F.lds + L_TB); LAS int* cn = (LAS int*)(F.lds + L_CN);
        if (F.tid < NEXP) cn[F.tid] = (int)__hip_atomic_load(ctl + CW_CNT + 16 * F.tid, RLX_AGENT);
        __syncthreads();
        if (F.tid == 0) { int t = 0; for (int e = 0; e < NEXP; ++e) { tb[e] = t; t += (cn[e] + 255) >> 8; } tb[NEXP] = t; }
        __syncthreads();
        { LAS int* te = (LAS int*)(F.lds + L_TE); for (int T = F.tid; T < tb[NEXP]; T += 512) { int e = 0; while (e < NEXP - 1 && tb[e + 1] <= T) ++e; te[T] = e; } }
        __syncthreads();
    }
    if (IN(7)) {
        const LAS int* tb = (const LAS int*)(F.lds + L_TB); const LAS int* cn = (const LAS int*)(F.lds + L_CN);
        pg8::Gemm g{(const bf16*)(ws + WS_H), (const bf16*)(ws + WS_WGU), NTOK, 2048, DM / 2, (size_t)2048 * DM / 2, (const int*)(ws + WS_LIST)};
        pg8::MoeOrder S{tb, cn, (const LAS int*)(F.lds + L_TE), 8, F.G, F.vcu, tb[NEXP]};
        pg8::EpiSwiglu E{ws + WS_ACT, args.in[17], MOE1_FP6 ? 1.f / (SC_H6 * SC_W6) : 1.f / (SC_H * SC_W)};
        pg8::gemm_phase<pg8::EpiSwiglu, pg8::MoeOrder, true, true, true, MOE1_FP6>(F.lds, g, S, E);
        phase_wd_tail2(F, args, S);
    } SEAM(7);
    if (IN(8)) {
        const LAS int* tb = (const LAS int*)(F.lds + L_TB); const LAS int* cn = (const LAS int*)(F.lds + L_CN);
        pg8::Gemm g{(const bf16*)(ws + WS_ACT), (const bf16*)(ws + WS_WD), MAX_MT * 256, DM, DFF / 2, (size_t)DM * DFF / 2, nullptr};
        pg8::MoeOrder S{tb, cn, (const LAS int*)(F.lds + L_TE), 4, F.G, F.vcu, tb[NEXP], true};
        pg8::EpiScatter E{ws + WS_Y, SC_Y / (SC_ACT * SC_W), args.in[19]};
        pg8::gemm_phase<pg8::EpiScatter, pg8::MoeOrder, true, false, true>(F.lds, g, S, E);
    } SEAM(8);
    if (IN(9)) { phase_final(F, args); }
#undef IN
#undef SEAM
}

extern "C" void kernel_launch(void* const* d_in, const int* in_sizes, int n_in, void* d_out, int out_size, void* d_ws, size_t ws_size, hipStream_t stream) {
    static int grid = 0;
    if (grid == 0) {
        if (n_in != 21 || in_sizes[0] != NTOK * DM || out_size != NTOK * DM || ws_size < WS_END) { fprintf(stderr, "kernel_launch: unexpected shapes / workspace (n_in %d, in0 %d, out %d, ws %zu, need %zu)\n", n_in, n_in > 0 ? in_sizes[0] : -1, out_size, ws_size, (size_t)WS_END); grid = -1; return; }
        int dev = 0, cus = 0, per_cu = 0;
        if (hipGetDevice(&dev) != hipSuccess || hipDeviceGetAttribute(&cus, hipDeviceAttributeMultiprocessorCount, dev) != hipSuccess) { grid = -1; return; }
        if (hipFuncSetAttribute((const void*)hymba_fwd, hipFuncAttributeMaxDynamicSharedMemorySize, LDS_BYTES) != hipSuccess) { fprintf(stderr, "kernel_launch: hipFuncSetAttribute failed\n"); grid = -1; return; }
        if (hipOccupancyMaxActiveBlocksPerMultiprocessor(&per_cu, (const void*)hymba_fwd, 512, LDS_BYTES) != hipSuccess || per_cu < 1) fprintf(stderr, "kernel_launch: occupancy query reports %d\n", per_cu);
        (void)hipGetLastError();
        grid = cus;
    }
    if (grid < 0) return;
    if (hipMemsetAsync((char*)d_ws + WS_CTL, 0, CTL_ZERO_BYTES, stream) != hipSuccess) return;
    Args a{};
    for (int i = 0; i < 21; ++i) a.in[i] = (const float*)d_in[i];
    a.out = (float*)d_out; a.ws = (unsigned char*)d_ws;
#if MK_PER_PHASE
    for (int ph = 0; ph < N_PHASES; ++ph) { a.ph_lo = ph; a.ph_hi = ph + 1; hipLaunchKernelGGL(hymba_fwd, dim3(grid), dim3(512), LDS_BYTES, stream, a); }
#else
    a.ph_lo = 0; a.ph_hi = N_PHASES; hipLaunchKernelGGL(hymba_fwd, dim3(grid), dim3(512), LDS_BYTES, stream, a);
#endif
}
```
